# Optimizing an MI355X kernel written in HIP

```python
import math
import jax
import jax.numpy as jnp
from jax import lax
import numpy as np

D_MODEL = 1024
BATCH = 8
SEQ = 2048
DEPTH = 4

CTX_LEN = 256
GRID_W = 64
N_EVEN = (DEPTH + 1) // 2
N_ODD = DEPTH // 2
NORM_EPS = 1e-6
F32 = jnp.float32

LRU_WIDTH = D_MODEL
LRU_HEADS = 8
LRU_HEAD_DIM = LRU_WIDTH // LRU_HEADS
LRU_CONV = 4
LRU_C = 8.0

S5_WIDTH = D_MODEL // 2
S5_GROUP = 16
S5_GROUPS = S5_WIDTH // S5_GROUP
S5_STATE = 64
S5_DT_MIN = 1e-3
S5_DT_MAX = 1e-1

EVEN_SPLITS = (LRU_WIDTH, 2 * LRU_WIDTH, 2 * LRU_WIDTH + S5_WIDTH)
EVEN_IN = 2 * LRU_WIDTH + 2 * S5_WIDTH
EVEN_MIX = LRU_WIDTH + S5_WIDTH

MLA_HEADS = 8
MLA_Q_RANK = 384
MLA_KV_RANK = 256
MLA_NOPE = 128
MLA_ROPE = 64
MLA_V = 128
MLA_WIDTH = MLA_HEADS * MLA_V
MLA_SPLITS = (MLA_Q_RANK, MLA_Q_RANK + MLA_KV_RANK, MLA_Q_RANK + MLA_KV_RANK + MLA_ROPE)
MLA_IN = MLA_Q_RANK + MLA_KV_RANK + MLA_ROPE + MLA_WIDTH
MLA_SCALE = 1.0 / math.sqrt(MLA_NOPE + MLA_ROPE)
ROPE_AXIS = MLA_ROPE // 2
ROPE_BASE = 10000.0
Q_BLOCK = 128

kernel_name = 'hybrid_rglru_s5_mla_prefix_dit'


def rmsnorm(x, g):
    xf = x.astype(F32)
    y = xf * lax.rsqrt(jnp.mean(xf * xf, axis=-1, keepdims=True) + NORM_EPS)
    return (y * g.astype(F32)).astype(x.dtype)


def modulation(cond, w, b):
    return jnp.split(jax.nn.silu(cond) @ w + b, 3, axis=-1)


def dwconv_centred(u, w, b):
    L = u.shape[1]
    up = jnp.pad(u, ((0, 0), (LRU_CONV // 2, LRU_CONV - 1 - LRU_CONV // 2), (0, 0)))
    out = b
    for k in range(LRU_CONV):
        out = out + up[:, k:k + L] * w[k]
    return out


def _real_combine(e1, e2):
    a1, b1 = e1
    a2, b2 = e2
    return a1 * a2, a2 * b1 + b2


def real_scan(a, b, h0, reverse):
    a_cum, h = lax.associative_scan(_real_combine, (a, b), reverse=reverse, axis=1)
    if h0 is not None:
        h = h + a_cum * h0[:, None]
    return h


def _complex_combine(e1, e2):
    ar1, ai1, br1, bi1 = e1
    ar2, ai2, br2, bi2 = e2
    return (ar1 * ar2 - ai1 * ai2, ar1 * ai2 + ai1 * ar2,
            ar2 * br1 - ai2 * bi1 + br2, ar2 * bi1 + ai2 * br1 + bi2)


def complex_scan(a_re, a_im, b_re, b_im, h0, reverse):
    a_re = jnp.broadcast_to(a_re, b_re.shape)
    a_im = jnp.broadcast_to(a_im, b_re.shape)
    ar, ai, hr, hi = lax.associative_scan(_complex_combine, (a_re, a_im, b_re, b_im), reverse=reverse, axis=1)
    if h0 is not None:
        h0r, h0i = h0[0][:, None], h0[1][:, None]
        hr, hi = hr + ar * h0r - ai * h0i, hi + ar * h0i + ai * h0r
    return hr, hi


def rglru_coeffs(u, wr, br, wi, bi, lam):
    uh = u.reshape(*u.shape[:-1], LRU_HEADS, LRU_HEAD_DIM)
    r = jax.nn.sigmoid(jnp.einsum('blhi,hij->blhj', uh, wr.astype(F32)).reshape(u.shape) + br.astype(F32))
    i = jax.nn.sigmoid(jnp.einsum('blhi,hij->blhj', uh, wi.astype(F32)).reshape(u.shape) + bi.astype(F32))
    log_a = -LRU_C * r * jax.nn.softplus(-lam.astype(F32))
    a = jnp.exp(log_a)
    b = jnp.sqrt(-jnp.expm1(2.0 * log_a)) * (i * u)
    return a, b


def rglru_mix(x_ctx, x_lat, conv_w, conv_b, wr, br, wi, bi, lam, with_ctx):
    u_ctx = dwconv_centred(x_ctx, conv_w, conv_b).astype(F32)
    u_lat = dwconv_centred(x_lat, conv_w, conv_b).astype(F32)
    hs_ctx, hs_lat = [], []
    for d, rev in enumerate((False, True)):
        a_c, b_c = rglru_coeffs(u_ctx, wr[d], br[d], wi[d], bi[d], lam[d])
        h_c = real_scan(a_c, b_c, None, rev)
        h0 = h_c[:, 0] if rev else h_c[:, -1]
        a_l, b_l = rglru_coeffs(u_lat, wr[d], br[d], wi[d], bi[d], lam[d])
        hs_lat.append(real_scan(a_l, b_l, h0, rev))
        hs_ctx.append(h_c)
    y_lat = hs_lat[0] + hs_lat[1]
    y_ctx = hs_ctx[0] + hs_ctx[1] if with_ctx else None
    return y_ctx, y_lat


def s5_discretise(lam_re, lam_im, log_dt, b_re, b_im):
    lam_re = lam_re.astype(F32)
    lam_im = lam_im.astype(F32)
    dt = jnp.exp(log_dt.astype(F32))
    mag = jnp.exp(lam_re * dt)
    ab_re = mag * jnp.cos(lam_im * dt)
    ab_im = mag * jnp.sin(lam_im * dt)
    den = lam_re * lam_re + lam_im * lam_im
    nr = ab_re - 1.0
    f_re = (nr * lam_re + ab_im * lam_im) / den
    f_im = (ab_im * lam_re - nr * lam_im) / den
    b_re = b_re.astype(F32)
    b_im = b_im.astype(F32)
    bb_re = f_re[..., None] * b_re - f_im[..., None] * b_im
    bb_im = f_re[..., None] * b_im + f_im[..., None] * b_re
    return ab_re, ab_im, bb_re, bb_im


def s5_mix(u_ctx, u_lat, lam_re, lam_im, log_dt, b_re, b_im, c_re, c_im, d_skip, glu_w, glu_b, with_ctx):
    dtype = u_lat.dtype
    uc = u_ctx.astype(F32).reshape(*u_ctx.shape[:-1], S5_GROUPS, S5_GROUP)
    ul = u_lat.astype(F32).reshape(*u_lat.shape[:-1], S5_GROUPS, S5_GROUP)
    ys_ctx, ys_lat = [], []
    for d, rev in enumerate((False, True)):
        ab_re, ab_im, bb_re, bb_im = s5_discretise(lam_re[d], lam_im[d], log_dt[d], b_re[d], b_im[d])
        cr, ci = c_re[d].astype(F32), c_im[d].astype(F32)
        hc_re, hc_im = complex_scan(ab_re, ab_im,
                                    jnp.einsum('blgh,gph->blgp', uc, bb_re),
                                    jnp.einsum('blgh,gph->blgp', uc, bb_im), None, rev)
        idx = 0 if rev else -1
        hl_re, hl_im = complex_scan(ab_re, ab_im,
                                    jnp.einsum('blgh,gph->blgp', ul, bb_re),
                                    jnp.einsum('blgh,gph->blgp', ul, bb_im),
                                    (hc_re[:, idx], hc_im[:, idx]), rev)
        ys_lat.append(jnp.einsum('ghp,blgp->blgh', cr, hl_re) - jnp.einsum('ghp,blgp->blgh', ci, hl_im))
        if with_ctx:
            ys_ctx.append(jnp.einsum('ghp,blgp->blgh', cr, hc_re) - jnp.einsum('ghp,blgp->blgh', ci, hc_im))

    def finish(ys, u):
        y = ys[0] + ys[1] + d_skip.astype(F32) * u
        y = jax.nn.gelu(y.reshape(*y.shape[:2], S5_WIDTH)).astype(dtype)
        return y * jax.nn.sigmoid(y @ glu_w + glu_b)

    y_lat = finish(ys_lat, ul)
    y_ctx = finish(ys_ctx, uc) if with_ctx else None
    return y_ctx, y_lat


def even_mix(h_ctx, h_lat, w_in, conv_w, conv_b, wr, br, wi, bi, lam, lam_re, lam_im, log_dt,
             b_re, b_im, c_re, c_im, d_skip, glu_w, glu_b, w_out, with_ctx):
    xa_c, ga_c, ub_c, gb_c = jnp.split(h_ctx @ w_in, EVEN_SPLITS, axis=-1)
    xa_l, ga_l, ub_l, gb_l = jnp.split(h_lat @ w_in, EVEN_SPLITS, axis=-1)
    ya_c, ya_l = rglru_mix(xa_c, xa_l, conv_w, conv_b, wr, br, wi, bi, lam, with_ctx)
    yb_c, yb_l = s5_mix(ub_c, ub_l, lam_re, lam_im, log_dt, b_re, b_im, c_re, c_im, d_skip, glu_w, glu_b, with_ctx)

    def merge(ya, ga, yb, gb):
        return jnp.concatenate([ya.astype(ga.dtype) * jax.nn.silu(ga), yb * jax.nn.silu(gb)], axis=-1) @ w_out

    out_lat = merge(ya_l, ga_l, yb_l, gb_l)
    out_ctx = merge(ya_c, ga_c, yb_c, gb_c) if with_ctx else None
    return out_ctx, out_lat


def axial_rope(n_tokens):
    rows = n_tokens // GRID_W
    row = jnp.repeat(jnp.arange(rows, dtype=F32), GRID_W)
    col = jnp.tile(jnp.arange(GRID_W, dtype=F32), rows)
    inv = ROPE_BASE ** (-jnp.arange(0, ROPE_AXIS, 2, dtype=F32) / ROPE_AXIS)
    ang = jnp.concatenate([row[:, None] * inv, col[:, None] * inv], axis=-1)
    return jnp.cos(ang), jnp.sin(ang)


def apply_rope(x, cos, sin):
    x1, x2 = jnp.split(x.astype(F32), 2, axis=-1)
    return jnp.concatenate([x1 * cos - x2 * sin, x2 * cos + x1 * sin], axis=-1).astype(x.dtype)


def attend(qn, qr, kn, kr, v):
    s = jnp.einsum('bqhd,bkhd->bhqk', qn, kn) + jnp.einsum('bqhr,bkr->bhqk', qr, kr)
    p = jax.nn.softmax(s.astype(F32) * MLA_SCALE, axis=-1)
    return jnp.einsum('bhqk,bkhd->bqhd', p.astype(v.dtype), v)


def mla_mix(h_ctx, h_lat, w_in, q_norm, w_uq, kv_norm, w_ukv, w_out, with_ctx):
    def project(h):
        cq, ckv, kr, gate = jnp.split(h @ w_in, MLA_SPLITS, axis=-1)
        q = (rmsnorm(cq, q_norm) @ w_uq).reshape(*h.shape[:2], MLA_HEADS, MLA_NOPE + MLA_ROPE)
        kv = (rmsnorm(ckv, kv_norm) @ w_ukv).reshape(*h.shape[:2], MLA_HEADS, MLA_NOPE + MLA_V)
        return q[..., :MLA_NOPE], q[..., MLA_NOPE:], kv[..., :MLA_NOPE], kr, kv[..., MLA_NOPE:], gate

    qn_c, qr_c, kn_c, kr_c, v_c, g_c = project(h_ctx)
    qn_l, qr_l, kn_l, kr_l, v_l, g_l = project(h_lat)
    bsz, n_lat = h_lat.shape[0], h_lat.shape[1]
    cos, sin = axial_rope(n_lat)
    qr_l = apply_rope(qr_l, cos[:, None], sin[:, None])
    kr_l = apply_rope(kr_l, cos, sin)
    kn = jnp.concatenate([kn_c, kn_l], axis=1)
    kr = jnp.concatenate([kr_c, kr_l], axis=1)
    v = jnp.concatenate([v_c, v_l], axis=1)
    nb = n_lat // Q_BLOCK
    qn_b = qn_l.reshape(bsz, nb, Q_BLOCK, MLA_HEADS, MLA_NOPE).swapaxes(0, 1)
    qr_b = qr_l.reshape(bsz, nb, Q_BLOCK, MLA_HEADS, MLA_ROPE).swapaxes(0, 1)
    o_l = lax.map(lambda qs: attend(qs[0], qs[1], kn, kr, v), (qn_b, qr_b))
    o_l = o_l.swapaxes(0, 1).reshape(bsz, n_lat, MLA_WIDTH)
    out_lat = (o_l * jax.nn.silu(g_l)) @ w_out
    out_ctx = None
    if with_ctx:
        o_c = attend(qn_c, qr_c, kn_c, kr_c, v_c).reshape(bsz, h_ctx.shape[1], MLA_WIDTH)
        out_ctx = (o_c * jax.nn.silu(g_c)) @ w_out
    return out_ctx, out_lat


def setup_inputs(seed: int = 0) -> dict:
    key = jax.random.key(seed)
    ks = iter(jax.random.split(key, 48))

    def nrm(shape, scale):
        return jax.random.normal(next(ks), shape, F32) * scale

    def gain(shape):
        return 1.0 + nrm(shape, 0.05)

    D = D_MODEL
    G, P, H = S5_GROUPS, S5_STATE, S5_GROUP
    v = jax.random.uniform(next(ks), (N_EVEN, 2, LRU_WIDTH), F32, minval=0.9, maxval=0.999)
    a0 = v ** (1.0 / LRU_C)
    lru_lam = jnp.log(a0) - jnp.log1p(-a0)
    s5_log_dt = jax.random.uniform(next(ks), (N_EVEN, 2, G, P), F32,
                                   minval=math.log(S5_DT_MIN), maxval=math.log(S5_DT_MAX))
    return {
        'x': nrm((BATCH, SEQ, D), 1.0),
        'c': nrm((BATCH, D), 1.0),
        'ctx': nrm((BATCH, CTX_LEN, D), 1.0),
        'c_ctx': nrm((D,), 1.0),
        'norm_g': gain((DEPTH, D)),
        'mod_w': nrm((DEPTH, D, 3 * D), 0.5 * D ** -0.5),
        'mod_b': nrm((DEPTH, 3 * D), 0.01),
        'ev_w_in': nrm((N_EVEN, D, EVEN_IN), D ** -0.5),
        'lru_conv_w': nrm((N_EVEN, LRU_CONV, LRU_WIDTH), LRU_CONV ** -0.5),
        'lru_conv_b': nrm((N_EVEN, LRU_WIDTH), 0.01),
        'lru_wr': nrm((N_EVEN, 2, LRU_HEADS, LRU_HEAD_DIM, LRU_HEAD_DIM), LRU_HEAD_DIM ** -0.5),
        'lru_br': nrm((N_EVEN, 2, LRU_WIDTH), 0.01),
        'lru_wi': nrm((N_EVEN, 2, LRU_HEADS, LRU_HEAD_DIM, LRU_HEAD_DIM), LRU_HEAD_DIM ** -0.5),
        'lru_bi': nrm((N_EVEN, 2, LRU_WIDTH), 0.01),
        'lru_lam': lru_lam,
        's5_lam_re': -0.5 * jnp.exp(nrm((N_EVEN, 2, G, P), 0.05)),
        's5_lam_im': jnp.pi * jnp.arange(P, dtype=F32) + nrm((N_EVEN, 2, G, P), 0.01),
        's5_log_dt': s5_log_dt,
        's5_b_re': nrm((N_EVEN, 2, G, P, H), (2.0 * H) ** -0.5),
        's5_b_im': nrm((N_EVEN, 2, G, P, H), (2.0 * H) ** -0.5),
        's5_c_re': nrm((N_EVEN, 2, G, H, P), P ** -0.5),
        's5_c_im': nrm((N_EVEN, 2, G, H, P), P ** -0.5),
        's5_d': nrm((N_EVEN, G, H), 1.0),
        's5_glu_w': nrm((N_EVEN, S5_WIDTH, S5_WIDTH), S5_WIDTH ** -0.5),
        's5_glu_b': nrm((N_EVEN, S5_WIDTH), 0.01),
        'ev_w_out': nrm((N_EVEN, EVEN_MIX, D), EVEN_MIX ** -0.5),
        'mla_w_in': nrm((N_ODD, D, MLA_IN), D ** -0.5),
        'mla_q_norm': gain((N_ODD, MLA_Q_RANK)),
        'mla_w_uq': nrm((N_ODD, MLA_Q_RANK, MLA_HEADS * (MLA_NOPE + MLA_ROPE)), MLA_Q_RANK ** -0.5),
        'mla_kv_norm': gain((N_ODD, MLA_KV_RANK)),
        'mla_w_ukv': nrm((N_ODD, MLA_KV_RANK, MLA_HEADS * (MLA_NOPE + MLA_V)), MLA_KV_RANK ** -0.5),
        'mla_w_out': nrm((N_ODD, MLA_WIDTH, D), MLA_WIDTH ** -0.5),
        'final_g': gain((D,)),
    }


def reference(x, c, ctx, c_ctx, norm_g, mod_w, mod_b,
              ev_w_in, lru_conv_w, lru_conv_b, lru_wr, lru_br, lru_wi, lru_bi, lru_lam,
              s5_lam_re, s5_lam_im, s5_log_dt, s5_b_re, s5_b_im, s5_c_re, s5_c_im, s5_d,
              s5_glu_w, s5_glu_b, ev_w_out,
              mla_w_in, mla_q_norm, mla_w_uq, mla_kv_norm, mla_w_ukv, mla_w_out,
              final_g):
    ctx_s = ctx
    for l in range(DEPTH):
        with_ctx = l < DEPTH - 1
        sh_l, sc_l, gt_l = modulation(c, mod_w[l], mod_b[l])
        sh_c, sc_c, gt_c = modulation(c_ctx, mod_w[l], mod_b[l])
        n_lat = rmsnorm(x, norm_g[l]) * (1.0 + sc_l[:, None]) + sh_l[:, None]
        n_ctx = rmsnorm(ctx_s, norm_g[l]) * (1.0 + sc_c) + sh_c
        if l % 2 == 0:
            e = l // 2
            o_ctx, o_lat = even_mix(n_ctx, n_lat, ev_w_in[e], lru_conv_w[e], lru_conv_b[e],
                                    lru_wr[e], lru_br[e], lru_wi[e], lru_bi[e], lru_lam[e],
                                    s5_lam_re[e], s5_lam_im[e], s5_log_dt[e], s5_b_re[e], s5_b_im[e],
                                    s5_c_re[e], s5_c_im[e], s5_d[e], s5_glu_w[e], s5_glu_b[e],
                                    ev_w_out[e], with_ctx)
        else:
            o = l // 2
            o_ctx, o_lat = mla_mix(n_ctx, n_lat, mla_w_in[o], mla_q_norm[o], mla_w_uq[o],
                                   mla_kv_norm[o], mla_w_ukv[o], mla_w_out[o], with_ctx)
        x = x + gt_l[:, None] * o_lat
        if with_ctx:
            ctx_s = ctx_s + gt_c * o_ctx
    return rmsnorm(x, final_g)
```

```cpp
#include <hip/hip_runtime.h>
#include <hip/hip_cooperative_groups.h>
#include <cstdio>
#include <cstdint>
#include <cmath>

typedef unsigned short bf16_t;
typedef short bf16x8 __attribute__((ext_vector_type(8)));
typedef float f32x4 __attribute__((ext_vector_type(4)));
typedef unsigned u32x2 __attribute__((ext_vector_type(2)));

constexpr int D = 1024, NB = 8, SEQ = 2048, CTX = 256, SALL = 2304, NTOK = NB * SALL;
constexpr int DEPTH = 4;
constexpr int EVEN_IN = 3072, EVEN_MIX = 1536, S5W = 512, S5G = 32, S5P = 64, S5H = 16;
constexpr int MLA_IN = 1728, QR = 384, KVR = 256, ROPE = 64, NOPE = 128, VD = 128, HEADS = 8, QW = 1536, KVW = 2048;

constexpr size_t OFF_WBF  = 0;
constexpr size_t SZ_WBF   = 40u << 20;
constexpr size_t OFF_MOD  = OFF_WBF + SZ_WBF;
constexpr size_t SZ_MOD   = 4 * 9 * 3072 * 4;
constexpr size_t OFF_MISC = OFF_MOD + ((SZ_MOD + 255) / 256) * 256;
constexpr size_t SZ_MISC  = 256 << 10;
constexpr size_t OFF_CTXS = OFF_MISC + SZ_MISC;
constexpr size_t SZ_CTXS  = (size_t)NB * CTX * D * 4;
constexpr size_t OFF_TAB  = OFF_CTXS + SZ_CTXS;
constexpr size_t SZ_TAB   = 18u << 20;
constexpr size_t OFF_ACT  = OFF_TAB + SZ_TAB;
constexpr size_t SZ_N   = (size_t)NTOK * D * 2;
constexpr size_t E_N    = OFF_ACT;
constexpr size_t E_UB   = E_N + SZ_N;
constexpr size_t E_MRG  = E_UB + (size_t)NTOK * 512 * 2;
constexpr size_t E_F    = E_MRG + (size_t)NTOK * 1536 * 2;
constexpr size_t E_YB   = E_F + (size_t)NTOK * 512 * 2;
constexpr size_t E_END  = E_YB + (size_t)NTOK * 512 * 2;
constexpr size_t O_KV   = OFF_ACT;
constexpr size_t O_N    = OFF_ACT;
constexpr size_t O_CQ   = O_KV + (size_t)NTOK * KVW * 2;
constexpr size_t O_CKV  = O_CQ + (size_t)NTOK * QR * 2;
constexpr size_t O_KR   = O_CKV + (size_t)NTOK * KVR * 2;
constexpr size_t O_MSG  = O_KR + (size_t)NTOK * ROPE * 2;
constexpr size_t O_SSP  = O_MSG + (size_t)NTOK * D * 2;
constexpr size_t O_END  = O_SSP + (size_t)NTOK * 16 * 4;
constexpr size_t OFF_SSX = O_END > E_END ? O_END : E_END;
constexpr size_t OFF_X16 = OFF_SSX + (size_t)NTOK * 16 * 4;
constexpr size_t WS_NEED = OFF_X16 + (size_t)8 * 2048 * 1024 * 2;

constexpr size_t WE_SZ = 3145728 + 1572864 + 262144 + 524288, WO_SZ = 1835008 + 589824 + 524288 + 1048576;
constexpr size_t WE_IN = 0, WE_OUT = 3145728, WE_GLU = WE_OUT + 1572864, WE_LRU = WE_GLU + 262144;
constexpr size_t WO_BASE = 2 * WE_SZ, WO_IN = 0, WO_UQ = 1835008, WO_UKV = WO_UQ + 589824, WO_OUT = WO_UKV + 524288;
constexpr size_t OFF_SHW = OFF_WBF + (2 * WE_SZ + 2 * WO_SZ) * 2;
constexpr size_t OFF_GM = OFF_SHW + 4 * 9 * 3072 * 4;
static_assert(OFF_GM + 4 * 9 * 1024 * 4 <= SZ_WBF, "weights");
constexpr size_t OFF_ROPE = OFF_MISC;
constexpr size_t OFF_BAR  = OFF_MISC + 16384;

struct Params {
    const float* in[33];
    float* xout;
    char* ws;
};

__device__ __forceinline__ bf16_t f2bf(float f) { unsigned u = __float_as_uint(f); u += 0x7fffu + ((u >> 16) & 1u); return (bf16_t)(u >> 16); }
__device__ __forceinline__ float bf2f(bf16_t h) { return __uint_as_float((unsigned)h << 16); }
__device__ __forceinline__ float silu_f(float x) { return x / (1.f + expf(-x)); }
__device__ __forceinline__ float sigmoid_f(float x) { return 1.f / (1.f + expf(-x)); }
__device__ __forceinline__ float gelu_tanh(float x) { return 0.5f * x * (1.f + tanhf(0.7978845608028654f * (x + 0.044715f * x * x * x))); }
__device__ __forceinline__ int row_cond(int r) { int b = r / SALL; int s = r - b * SALL; return s < CTX ? 8 : b; }
__device__ __forceinline__ bf16_t* resid_row(const Params& p, int r) {
    int b = r / SALL, s = r - b * SALL;
    return s < CTX ? (bf16_t*)(p.ws + OFF_CTXS) + (size_t)(b * CTX + s) * D : (bf16_t*)(p.ws + OFF_X16) + (size_t)(b * SEQ + (s - CTX)) * D;
}

constexpr int NTHR = 512;
constexpr int SMEM_BYTES = 163840;

__device__ __forceinline__ unsigned cvtpk(float lo, float hi);
__device__ __forceinline__ unsigned pack2bf(float a, float b) { return (unsigned)f2bf(a) | ((unsigned)f2bf(b) << 16); }
__device__ __forceinline__ void st_bf4(bf16_t* p, f32x4 v) { u32x2 w; w.x = pack2bf(v[0], v[1]); w.y = pack2bf(v[2], v[3]); *(u32x2*)p = w; }
__device__ __forceinline__ f32x4 ld_bf4(const bf16_t* p) { u32x2 w = *(const u32x2*)p; f32x4 v; v[0] = __uint_as_float(w.x << 16); v[1] = __uint_as_float(w.x & 0xffff0000u); v[2] = __uint_as_float(w.y << 16); v[3] = __uint_as_float(w.y & 0xffff0000u); return v; }

typedef unsigned u32x4v __attribute__((ext_vector_type(4)));
__device__ __forceinline__ void st_bf8(bf16_t* p, f32x4 a, f32x4 b) { u32x4v w; w.x = cvtpk(a[0], a[1]); w.y = cvtpk(a[2], a[3]); w.z = cvtpk(b[0], b[1]); w.w = cvtpk(b[2], b[3]); *(u32x4v*)p = w; }
__device__ __forceinline__ void ld_bf8(const bf16_t* p, f32x4& a, f32x4& b) { u32x4v w = *(const u32x4v*)p;
    a[0] = __uint_as_float(w.x << 16); a[1] = __uint_as_float(w.x & 0xffff0000u); a[2] = __uint_as_float(w.y << 16); a[3] = __uint_as_float(w.y & 0xffff0000u);
    b[0] = __uint_as_float(w.z << 16); b[1] = __uint_as_float(w.z & 0xffff0000u); b[2] = __uint_as_float(w.w << 16); b[3] = __uint_as_float(w.w & 0xffff0000u); }
__device__ __forceinline__ float sigmoid_fast(float x) { return __builtin_amdgcn_rcpf(1.f + __builtin_amdgcn_exp2f(-1.4426950408889634f * x)); }
__device__ __forceinline__ float silu_fast(float x) { return x * sigmoid_fast(x); }

struct WDesc { const float* src; const float* kscale; bf16_t* dst; int K, N, Npad, ldw; float scale; };
__device__ __forceinline__ WDesc get_wdesc(const Params& p, int id) {
    bf16_t* wb = (bf16_t*)(p.ws + OFF_WBF); WDesc d; d.kscale = nullptr; d.scale = 1.f;
    if (id < 70) { int e = id / 35, j = id % 35; bf16_t* base = wb + e * WE_SZ;
        if (j == 0) { d.src = p.in[7] + (size_t)e * 1024 * 3072; d.K = 1024; d.N = 3072; d.Npad = 3072; d.ldw = 3072; d.dst = base + WE_IN; }
        else if (j == 1) { d.src = p.in[25] + (size_t)e * 1536 * 1024; d.K = 1536; d.N = 1024; d.Npad = 1024; d.ldw = 1024; d.dst = base + WE_OUT; }
        else if (j == 2) { d.src = p.in[23] + (size_t)e * 512 * 512; d.K = 512; d.N = 512; d.Npad = 512; d.ldw = 512; d.dst = base + WE_GLU; }
        else { int q = j - 3; int h = q & 7, gate = (q >> 3) & 1, dd = q >> 4;
            d.src = p.in[gate ? 12 : 10] + ((size_t)((e * 2 + dd) * 8 + h)) * 16384; d.K = 128; d.N = 128; d.Npad = 128; d.ldw = 128; d.scale = -1.4426950408889634f;
            d.dst = base + WE_LRU + (size_t)h * 512 * 128 + (size_t)((dd * 2 + gate) * 128) * 128; }
    } else { int o = (id - 70) / 4, j = (id - 70) % 4; bf16_t* base = wb + WO_BASE + o * WO_SZ;
        if (j == 0) { d.src = p.in[26] + (size_t)o * 1024 * 1728; d.K = 1024; d.N = 1728; d.Npad = 1792; d.ldw = 1728; d.dst = base + WO_IN; }
        else if (j == 1) { d.src = p.in[28] + (size_t)o * 384 * 1536; d.K = 384; d.N = 1536; d.Npad = 1536; d.ldw = 1536; d.dst = base + WO_UQ; d.kscale = p.in[27] + o * 384; }
        else if (j == 2) { d.src = p.in[30] + (size_t)o * 256 * 2048; d.K = 256; d.N = 2048; d.Npad = 2048; d.ldw = 2048; d.dst = base + WO_UKV; d.kscale = p.in[29] + o * 256; }
        else { d.src = p.in[31] + (size_t)o * 1024 * 1024; d.K = 1024; d.N = 1024; d.Npad = 1024; d.ldw = 1024; d.dst = base + WO_OUT; }
    }
    return d;
}
constexpr int N_WDESC = 78;
__device__ void phase_prep_weights(const Params& p, char* smem) {
    float* tile = (float*)smem;
    int tid_ = threadIdx.x; asm volatile("" : "+v"(tid_)); const int tid = tid_;
    const int kk0 = tid >> 4, c4 = (tid & 15) * 4;
    int id = 0, base = 0; WDesc d = get_wdesc(p, 0); int tk = d.K / 64, nt = tk * (d.Npad / 64);
    int t = blockIdx.x;
    auto seek = [&](int tt) { while (id < N_WDESC && tt >= base + nt) { base += nt; ++id; if (id < N_WDESC) { d = get_wdesc(p, id); tk = d.K / 64; nt = tk * (d.Npad / 64); } } };
    auto ldtile = [&](const WDesc& dd, int k0, int n0, f32x4& v0, f32x4& v1) {
        const int n = n0 + c4; const bool in = n < dd.N;
        v0 = in ? *(const f32x4*)(dd.src + (size_t)(k0 + kk0) * dd.ldw + n) : (f32x4){0.f, 0.f, 0.f, 0.f};
        v1 = in ? *(const f32x4*)(dd.src + (size_t)(k0 + kk0 + 32) * dd.ldw + n) : (f32x4){0.f, 0.f, 0.f, 0.f}; };
    seek(t);
    f32x4 a0, a1; WDesc dc = d; int k0c = 0, n0c = 0; bool have = id < N_WDESC;
    if (have) { int lt = t - base; k0c = (lt % tk) * 64; n0c = (lt / tk) * 64; ldtile(dc, k0c, n0c, a0, a1); }
    while (have) {
        const int tn = t + gridDim.x; seek(tn);
        f32x4 b0 = {0.f, 0.f, 0.f, 0.f}, b1 = {0.f, 0.f, 0.f, 0.f}; WDesc dn = d; int k0n = 0, n0n = 0; const bool haven = id < N_WDESC;
        if (haven) { int lt = tn - base; k0n = (lt % tk) * 64; n0n = (lt / tk) * 64; ldtile(dn, k0n, n0n, b0, b1); }
        const float s0 = (dc.kscale ? dc.kscale[k0c + kk0] * dc.scale : dc.scale), s1 = (dc.kscale ? dc.kscale[k0c + kk0 + 32] * dc.scale : dc.scale);
        __syncthreads();
#pragma unroll
        for (int j = 0; j < 4; ++j) { tile[kk0 * 65 + c4 + j] = a0[j] * s0; tile[(kk0 + 32) * 65 + c4 + j] = a1[j] * s1; }
        __syncthreads();
        { int n = tid >> 3, k8 = (tid & 7) * 8; unsigned w[4];
#pragma unroll
          for (int j = 0; j < 4; ++j) w[j] = cvtpk(tile[(k8 + 2 * j) * 65 + n], tile[(k8 + 2 * j + 1) * 65 + n]);
          uint4 o; o.x = w[0]; o.y = w[1]; o.z = w[2]; o.w = w[3];
          *(uint4*)(dc.dst + (size_t)(n0c + n) * dc.K + k0c + k8) = o; }
        t = tn; have = haven; dc = dn; k0c = k0n; n0c = n0n; a0 = b0; a1 = b1;
    }
    if (blockIdx.x == 0) { float2* tab = (float2*)(p.ws + OFF_ROPE);
        for (int i = tid; i < 1024; i += NTHR) { int pos = i >> 4, f = i & 15; float inv = powf(10000.f, -(float)(2 * f) / 32.f); float ang = (float)pos * inv; tab[i] = make_float2(cosf(ang), sinf(ang)); } }
}

template <int MF> __device__ __forceinline__ void rope_rotate(f32x4 (&acc)[MF][4], int row0, int fr, int fq, const float2* tab) {
#pragma unroll
    for (int m = 0; m < MF; ++m) { int r = row0 + m * 16 + fr; int s = r % SALL; int t = s - CTX; if (t < 0) t = 0;
        const int pos = fq < 2 ? (t >> 6) : (t & 63);
#pragma unroll
        for (int tt = 0; tt < 2; ++tt) {
#pragma unroll
            for (int j = 0; j < 4; ++j) { float2 cs = tab[pos * 16 + ((8 * fq + 4 * tt + j) & 15)]; float a = acc[m][tt][j], b = acc[m][tt + 2][j];
                if (s >= CTX) { acc[m][tt][j] = a * cs.x - b * cs.y; acc[m][tt + 2][j] = b * cs.x + a * cs.y; } } } }
}
template <int MF, int NG, class Epi, int AMODE = 0>
__device__ void gemm_phase(const bf16_t* __restrict__ A, int lda, const bf16_t* __restrict__ Bt, int ldb, int M, int N, int K, const Epi& epi, char* smem, const float2* rope_tab) {
    constexpr int BM = 64 * MF, A_BYTES = BM * 128, B_BYTES = 128 * 128, STAGE = A_BYTES + B_BYTES;
    static_assert(3 * STAGE <= SMEM_BYTES - 16, "gemm lds");
    int tid_ = threadIdx.x; asm volatile("" : "+v"(tid_)); const int tid = tid_, wid = tid >> 6, lane = tid & 63, wm = wid >> 1, wn = wid & 1, fr = lane & 15, fq = lane >> 4;
    const int nM = M / BM, nN = N / 128, nk = K / 64;
    const int xcd = blockIdx.x & 7, jw = blockIdx.x >> 3, nj = gridDim.x >> 3;
    constexpr int MGC = 8 / NG; const int ng = xcd % NG, mg = xcd / NG, gn = nN / NG;
    const int npx = (nM - mg + MGC - 1) / MGC;
    const int ldr = tid >> 3, ldc = ((tid & 7) ^ (ldr & 7)) << 3;
    const int ldrB = (ldr & ~31) | (8 * ((ldr & 15) >> 2) + 4 * ((ldr & 31) >> 4) + (ldr & 3));
#define GEMM_AROW(pmx, pnx, i_) (AMODE == 0 ? A + (size_t)((pmx) * BM + (i_) * 64 + ldr) * lda + ldc \
        : A + ((size_t)(((pmx) * BM + (i_) * 64 + ldr) / 72) * SALL + (((pmx) * BM + (i_) * 64 + ldr) % 72) * 32 + (ldc >> 4)) * 512 + ((pnx) >> 1) * 16 + (ldc & 15))
#define GEMM_STAGE(buf, k0) do { char* As_ = smem + (buf) * STAGE; char* Bs_ = As_ + A_BYTES; \
        _Pragma("unroll") for (int i_ = 0; i_ < MF; ++i_) __builtin_amdgcn_global_load_lds((const unsigned*)(Ag[i_] + (AMODE == 0 ? (k0) : (k0) * 32)), (__attribute__((address_space(3))) unsigned*)(As_ + tid * 16 + i_ * 8192), 16, 0, 0); \
        _Pragma("unroll") for (int i_ = 0; i_ < 2; ++i_) __builtin_amdgcn_global_load_lds((const unsigned*)(Bg + (size_t)(i_ * 64) * ldb + (k0)), (__attribute__((address_space(3))) unsigned*)(Bs_ + tid * 16 + i_ * 8192), 16, 0, 0); } while (0)
#define GEMM_LOADF(AF, WF, bufi, ks) do { const char* As_ = smem + (bufi) * STAGE; const char* Bs_ = As_ + A_BYTES; \
        _Pragma("unroll") for (int n_ = 0; n_ < 4; ++n_) { int row_ = wn * 64 + n_ * 16 + fr; WF[n_] = *(const bf16x8*)(Bs_ + row_ * 128 + ((((ks) * 4 + fq) ^ (row_ & 7)) << 4)); } \
        _Pragma("unroll") for (int m_ = 0; m_ < MF; ++m_) { int row_ = wm * (16 * MF) + m_ * 16 + fr; AF[m_] = *(const bf16x8*)(As_ + row_ * 128 + ((((ks) * 4 + fq) ^ (row_ & 7)) << 4)); } } while (0)
#define SBAR() __builtin_amdgcn_sched_barrier(0)
#define GEMM_STAGE_A(buf, k0) do { char* As_ = smem + (buf) * STAGE; \
        _Pragma("unroll") for (int i_ = 0; i_ < MF; ++i_) __builtin_amdgcn_global_load_lds((const unsigned*)(Ag[i_] + (AMODE == 0 ? (k0) : (k0) * 32)), (__attribute__((address_space(3))) unsigned*)(As_ + tid * 16 + i_ * 8192), 16, 0, 0); } while (0)
#define GEMM_STAGE_B(buf, k0) do { char* Bs_ = smem + (buf) * STAGE + A_BYTES; \
        _Pragma("unroll") for (int i_ = 0; i_ < 2; ++i_) __builtin_amdgcn_global_load_lds((const unsigned*)(Bg + (size_t)(i_ * 64) * ldb + (k0)), (__attribute__((address_space(3))) unsigned*)(Bs_ + tid * 16 + i_ * 8192), 16, 0, 0); } while (0)
#define GEMM_LOADW(WF, bufi, ks) do { const char* Bs_ = smem + (bufi) * STAGE + A_BYTES; \
        _Pragma("unroll") for (int n_ = 0; n_ < 4; ++n_) { int row_ = wn * 64 + n_ * 16 + fr; WF[n_] = *(const bf16x8*)(Bs_ + row_ * 128 + ((((ks) * 4 + fq) ^ (row_ & 7)) << 4)); } } while (0)
#define GEMM_LOADA(AF, bufi, ks) do { const char* As_ = smem + (bufi) * STAGE; \
        _Pragma("unroll") for (int m_ = 0; m_ < MF; ++m_) { int row_ = wm * (16 * MF) + m_ * 16 + fr; AF[m_] = *(const bf16x8*)(As_ + row_ * 128 + ((((ks) * 4 + fq) ^ (row_ & 7)) << 4)); } } while (0)
#define GEMM_MMA_ROW(m_, AF, WF) do { _Pragma("unroll") for (int n_ = 0; n_ < 4; ++n_) acc[m_][n_] = __builtin_amdgcn_mfma_f32_16x16x32_bf16(WF[n_], AF[m_], acc[m_][n_], 0, 0, 0); } while (0)
#define GEMM_MMA(AF, WF) do { __builtin_amdgcn_s_setprio(1); \
        _Pragma("unroll") for (int m_ = 0; m_ < MF; ++m_) _Pragma("unroll") for (int n_ = 0; n_ < 4; ++n_) acc[m_][n_] = __builtin_amdgcn_mfma_f32_16x16x32_bf16(WF[n_], AF[m_], acc[m_][n_], 0, 0, 0); \
        __builtin_amdgcn_s_setprio(0); } while (0)
#define GEMM_TILE(itx, PM, PN) do { PM = mg + MGC * ((itx) / gn); PN = ng * gn + (itx) % gn; } while (0)
    const int nitems = npx * gn;
    int it = jw;
    if (it < nitems) {
        int pm, pn; GEMM_TILE(it, pm, pn);
        const bf16_t* Ag[MF];
#pragma unroll
        for (int i = 0; i < MF; ++i) Ag[i] = GEMM_AROW(pm, pn, i);
        const bf16_t* Bg = Bt + (size_t)(pn * 128 + ldrB) * ldb + ldc;
        __syncthreads();
        GEMM_STAGE(0, 0); if (nk > 1) GEMM_STAGE(1, 64);
    }
    for (; it < nitems; it += nj) {
        int pm, pn; GEMM_TILE(it, pm, pn);
        const int brow = pm * BM, bcol = pn * 128;
        f32x4 acc[MF][4];
#pragma unroll
        for (int m = 0; m < MF; ++m)
#pragma unroll
            for (int n = 0; n < 4; ++n) acc[m][n] = (f32x4){0.f, 0.f, 0.f, 0.f};
        const bf16_t* Ag[MF];
#pragma unroll
        for (int i = 0; i < MF; ++i) Ag[i] = GEMM_AROW(pm, pn, i);
        const bf16_t* Bg = Bt + (size_t)(bcol + ldrB) * ldb + ldc;
        asm volatile("s_waitcnt vmcnt(0)" ::: "memory");
        asm volatile("" ::: "memory"); __builtin_amdgcn_s_barrier(); asm volatile("" ::: "memory");
        bf16x8 a0[MF], w0[4], a1[MF], w1[4];
        GEMM_LOADF(a0, w0, 0, 0);
        __builtin_amdgcn_s_waitcnt(0xC07F);
        int buf = 0;
        for (int kt = 0; kt < nk; ++kt) {
            const bool more = kt + 2 < nk; int nb2 = buf + 2; if (nb2 >= 3) nb2 -= 3;
            SBAR(); GEMM_MMA_ROW(0, a0, w0); SBAR(); GEMM_LOADW(w1, buf, 1); SBAR();
            if (MF > 1) { GEMM_MMA_ROW(1, a0, w0); SBAR(); }
            GEMM_LOADA(a1, buf, 1); SBAR();
            if (more) GEMM_STAGE_A(nb2, (kt + 2) * 64);
            SBAR();
            if (MF > 2) { GEMM_MMA_ROW(2, a0, w0); SBAR(); }
            if (more) GEMM_STAGE_B(nb2, (kt + 2) * 64);
            SBAR();
            if (MF > 3) { GEMM_MMA_ROW(3, a0, w0); SBAR(); }
            if (kt + 1 < nk) {
                if (more) { if (MF == 4) asm volatile("s_waitcnt vmcnt(6)" ::: "memory"); else if (MF == 3) asm volatile("s_waitcnt vmcnt(5)" ::: "memory"); else asm volatile("s_waitcnt vmcnt(4)" ::: "memory"); }
                else asm volatile("s_waitcnt vmcnt(0)" ::: "memory");
            }
            __builtin_amdgcn_s_waitcnt(0xC07F);
            asm volatile("" ::: "memory"); __builtin_amdgcn_s_barrier(); asm volatile("" ::: "memory");
            int nb = buf + 1; if (nb >= 3) nb -= 3;
            const bool nxt = kt + 1 < nk;
            SBAR(); GEMM_MMA_ROW(0, a1, w1); SBAR(); if (nxt) GEMM_LOADW(w0, nb, 0); SBAR();
            if (MF > 1) { GEMM_MMA_ROW(1, a1, w1); SBAR(); }
            if (nxt) GEMM_LOADA(a0, nb, 0);
            SBAR();
            if (MF > 2) { GEMM_MMA_ROW(2, a1, w1); SBAR(); }
            if (MF > 3) { GEMM_MMA_ROW(3, a1, w1); SBAR(); }
            __builtin_amdgcn_s_waitcnt(0xC07F);
            buf = nb;
        }
        float rstd_m[MF]; f32x4 shw_n[4];
        if constexpr (Epi::HAS_PRE) {
            float* rs = (float*)(smem + 2 * STAGE);
            if (tid < 2 * BM) { const int rr = tid >> 1; const f32x4* s = (const f32x4*)(epi.SSX + (size_t)(brow + rr) * 16 + (tid & 1) * 8); const f32x4 a = s[0], b = s[1];
                float t = (a[0] + a[1]) + (a[2] + a[3]) + (b[0] + b[1]) + (b[2] + b[3]); t += __shfl_xor(t, 1);
                if ((tid & 1) == 0) rs[rr] = 1.0f / sqrtf(t * (1.f / 1024.f) + 1e-6f); }
            __syncthreads();
#pragma unroll
            for (int m = 0; m < MF; ++m) rstd_m[m] = rs[wm * (16 * MF) + m * 16 + fr];
            const float* shw = epi.shw_l + row_cond(brow) * 3072 + (bcol + wn * 64) + 8 * fq;
#pragma unroll
            for (int n = 0; n < 4; ++n) shw_n[n] = *(const f32x4*)(shw + 32 * (n >> 1) + 4 * (n & 1));
            __builtin_amdgcn_s_waitcnt(0xC07F);
            asm volatile("s_waitcnt vmcnt(0)" ::: "memory");
        }
        if (it + nj < nitems) { int pm2, pn2; GEMM_TILE(it + nj, pm2, pn2);
            const bf16_t* Bg2 = Bt + (size_t)(pn2 * 128 + ldrB) * ldb + ldc;
            { const bf16_t* Ag[MF];
#pragma unroll
              for (int i = 0; i < MF; ++i) Ag[i] = GEMM_AROW(pm2, pn2, i);
              const bf16_t* Bg = Bg2; GEMM_STAGE(0, 0); if (nk > 1) GEMM_STAGE(1, 64); } }
        const int row0 = brow + wm * (16 * MF), col0 = bcol + wn * 64;
        if constexpr (Epi::HAS_PRE) {
#pragma unroll
            for (int m = 0; m < MF; ++m)
#pragma unroll
                for (int n = 0; n < 4; ++n)
#pragma unroll
                    for (int j = 0; j < 4; ++j) acc[m][n][j] = acc[m][n][j] * rstd_m[m] + shw_n[n][j]; }
        if (Epi::HAS_ROWSS) { if (epi.rowss_block(col0)) {
#pragma unroll
            for (int m = 0; m < MF; ++m) { float s = 0.f;
#pragma unroll
                for (int n = 0; n < 4; ++n)
#pragma unroll
                    for (int j = 0; j < 4; ++j) s += acc[m][n][j] * acc[m][n][j];
                s += __shfl_xor(s, 16); s += __shfl_xor(s, 32);
                if (fq == 0) epi.rowss(row0 + m * 16 + fr, col0, s); } } }
        if (Epi::HAS_ROPE) { if (epi.rope_block(col0)) rope_rotate<MF>(acc, row0, fr, fq, rope_tab); }
        if constexpr (Epi::HAS_PRELOAD) {
            typename Epi::PL pl[MF][2];
#pragma unroll
            for (int m = 0; m < MF; ++m) { const int row = row0 + m * 16 + fr; const auto rc = epi.row_ctx(row);
#pragma unroll
                for (int g = 0; g < 2; ++g) pl[m][g] = epi.preload(rc, row, col0 + 32 * g + 8 * fq); }
#pragma unroll
            for (int m = 0; m < MF; ++m) { const int row = row0 + m * 16 + fr; const auto rc = epi.row_ctx(row); float ssq = 0.f;
#pragma unroll
                for (int g = 0; g < 2; ++g) ssq += epi.vec8p(rc, row, col0 + 32 * g + 8 * fq, acc[m][2 * g], acc[m][2 * g + 1], pl[m][g]);
                if (Epi::HAS_ROWSS_POST) { ssq += __shfl_xor(ssq, 16); ssq += __shfl_xor(ssq, 32); if (fq == 0) epi.rowss_post(row, col0, ssq); } }
        } else {
#pragma unroll
        for (int m = 0; m < MF; ++m) { const int row = row0 + m * 16 + fr; const auto rc = epi.row_ctx(row);
#pragma unroll
            for (int g = 0; g < 2; ++g) epi.vec8(rc, row, col0 + 32 * g + 8 * fq, acc[m][2 * g], acc[m][2 * g + 1]); }
        }
    }
#undef GEMM_AROW
#undef GEMM_STAGE
#undef GEMM_LOADF
#undef GEMM_MMA
#undef GEMM_STAGE_A
#undef GEMM_STAGE_B
#undef GEMM_LOADW
#undef GEMM_LOADA
#undef GEMM_MMA_ROW
#undef GEMM_TILE
}

struct NoCtx {};
struct PreCtx { float rstd; const float* shw; };
__device__ __forceinline__ PreCtx pre_ctx(const float* SSX, const float* shw_l, int r) { const f32x4* s = (const f32x4*)(SSX + (size_t)r * 16); f32x4 a = s[0], b = s[1], c = s[2], d = s[3];
    float t = (a[0] + a[1]) + (a[2] + a[3]) + (b[0] + b[1]) + (b[2] + b[3]) + (c[0] + c[1]) + (c[2] + c[3]) + (d[0] + d[1]) + (d[2] + d[3]);
    return PreCtx{1.0f / sqrtf(t * (1.f / 1024.f) + 1e-6f), shw_l + row_cond(r) * 3072}; }
struct VEpiEvenIn { static constexpr bool HAS_PRE = true; static constexpr bool HAS_PRELOAD = false; struct PL {}; static constexpr bool HAS_ROPE = false, HAS_ROWSS = false; bf16_t* XA; bf16_t* UB; bf16_t* MRG; const float* SSX; const float* shw_l;
    __device__ __forceinline__ bool rope_block(int) const { return false; }
    __device__ __forceinline__ bool rowss_block(int) const { return false; }
    __device__ __forceinline__ void rowss(int, int, float) const {}
    __device__ __forceinline__ NoCtx row_ctx(int) const { return NoCtx{}; }
    __device__ __forceinline__ void vec8(const NoCtx&, int r, int c, f32x4 lo, f32x4 hi) const {
        if (c < 1024) st_bf8(XA + (size_t)r * 1024 + c, lo, hi);
        else if (c < 2048) { for (int j = 0; j < 4; ++j) { lo[j] = silu_fast(lo[j]); hi[j] = silu_fast(hi[j]); } st_bf8(MRG + (size_t)r * 1536 + (c - 1024), lo, hi); }
        else if (c < 2560) st_bf8(UB + (size_t)r * 512 + (c - 2048), lo, hi);
        else { for (int j = 0; j < 4; ++j) { lo[j] = silu_fast(lo[j]); hi[j] = silu_fast(hi[j]); } st_bf8(MRG + (size_t)r * 1536 + 1024 + (c - 2560), lo, hi); }
    } };
struct VEpiGlu { static constexpr bool HAS_ROWSS_POST = false; __device__ __forceinline__ void rowss_post(int, int, float) const {} static constexpr bool HAS_PRE = false; static constexpr bool HAS_PRELOAD = true; struct PL { f32x4 y0, y1, g0, g1; }; static constexpr bool HAS_ROPE = false, HAS_ROWSS = false; const bf16_t* YB; bf16_t* MRG; const float* bias;
    __device__ __forceinline__ bool rope_block(int) const { return false; }
    __device__ __forceinline__ bool rowss_block(int) const { return false; }
    __device__ __forceinline__ void rowss(int, int, float) const {}
    __device__ __forceinline__ NoCtx row_ctx(int) const { return NoCtx{}; }
    __device__ __forceinline__ PL preload(const NoCtx&, int r, int c) const { PL q; ld_bf8(YB + (size_t)r * 512 + c, q.y0, q.y1); ld_bf8(MRG + (size_t)r * 1536 + 1024 + c, q.g0, q.g1); return q; }
    __device__ __forceinline__ float vec8p(const NoCtx&, int r, int c, f32x4 lo, f32x4 hi, const PL& q) const {
        f32x4 b0 = *(const f32x4*)(bias + c), b1 = *(const f32x4*)(bias + c + 4);
        for (int j = 0; j < 4; ++j) { lo[j] = q.y0[j] * sigmoid_fast(lo[j] + b0[j]) * q.g0[j]; hi[j] = q.y1[j] * sigmoid_fast(hi[j] + b1[j]) * q.g1[j]; }
        st_bf8(MRG + (size_t)r * 1536 + 1024 + c, lo, hi); return 0.f;
    } };
struct VEpiS5F { static constexpr bool HAS_PRE = false; static constexpr bool HAS_PRELOAD = false; struct PL {}; static constexpr bool HAS_ROPE = false, HAS_ROWSS = false; float* F;
    __device__ __forceinline__ bool rope_block(int) const { return false; }
    __device__ __forceinline__ bool rowss_block(int) const { return false; }
    __device__ __forceinline__ void rowss(int, int, float) const {}
    __device__ __forceinline__ NoCtx row_ctx(int) const { return NoCtx{}; }
    __device__ __forceinline__ void vec8(const NoCtx&, int r, int c, f32x4 lo, f32x4 hi) const { float* f = F + ((size_t)r * 32 + (c >> 8)) * 256 + (c & 255); *(f32x4*)f = lo; *(f32x4*)(f + 4) = hi; } };
struct ResidCtx { bf16_t* x; const float* g; const float* gm; };
struct VEpiResid { static constexpr bool HAS_ROWSS_POST = true; static constexpr bool HAS_PRE = false; static constexpr bool HAS_PRELOAD = true; struct PL { u32x4v xv; }; static constexpr bool HAS_ROPE = false, HAS_ROWSS = false;
    Params p; const float* mod; const float* gm_next; bf16_t* An; float* SSX;
    __device__ __forceinline__ bool rope_block(int) const { return false; }
    __device__ __forceinline__ bool rowss_block(int) const { return false; }
    __device__ __forceinline__ void rowss(int, int, float) const {}
    __device__ __forceinline__ void rowss_post(int r, int c0, float s) const { if (gm_next) SSX[(size_t)r * 16 + (c0 >> 6)] = s; }
    __device__ __forceinline__ ResidCtx row_ctx(int r) const { const int cd = row_cond(r); return ResidCtx{resid_row(p, r), mod + cd * 3072 + 2048, gm_next ? gm_next + cd * 1024 : nullptr}; }
    __device__ __forceinline__ PL preload(const ResidCtx& rc, int r, int c) const { PL q; q.xv = *(const u32x4v*)(rc.x + c); return q; }
    __device__ __forceinline__ float vec8p(const ResidCtx& rc, int r, int c, f32x4 lo, f32x4 hi, const PL& q) const {
        bf16_t* x = rc.x + c; f32x4 x0, x1; x0[0] = __uint_as_float(q.xv.x << 16); x0[1] = __uint_as_float(q.xv.x & 0xffff0000u); x0[2] = __uint_as_float(q.xv.y << 16); x0[3] = __uint_as_float(q.xv.y & 0xffff0000u);
        x1[0] = __uint_as_float(q.xv.z << 16); x1[1] = __uint_as_float(q.xv.z & 0xffff0000u); x1[2] = __uint_as_float(q.xv.w << 16); x1[3] = __uint_as_float(q.xv.w & 0xffff0000u); f32x4 g0 = *(const f32x4*)(rc.g + c), g1 = *(const f32x4*)(rc.g + c + 4);
        for (int j = 0; j < 4; ++j) { x0[j] += g0[j] * lo[j]; x1[j] += g1[j] * hi[j]; }
        st_bf8(x, x0, x1);
        float ss = 0.f;
        if (rc.gm) { f32x4 m0 = *(const f32x4*)(rc.gm + c), m1 = *(const f32x4*)(rc.gm + c + 4); f32x4 a0, a1;
            for (int j = 0; j < 4; ++j) { ss += x0[j] * x0[j] + x1[j] * x1[j]; a0[j] = x0[j] * m0[j]; a1[j] = x1[j] * m1[j]; }
            st_bf8(An + (size_t)r * 1024 + c, a0, a1); }
        return ss;
    } };
struct VEpiMlaIn { static constexpr bool HAS_PRE = true; static constexpr bool HAS_PRELOAD = false; struct PL {}; static constexpr bool HAS_ROPE = true, HAS_ROWSS = true; bf16_t* CQ; bf16_t* CKV; bf16_t* KR; bf16_t* MSG; float* SSP; const float* SSX; const float* shw_l;
    __device__ __forceinline__ bool rope_block(int c0) const { return c0 == 640; }
    __device__ __forceinline__ bool rowss_block(int c0) const { return c0 < 640; }
    __device__ __forceinline__ void rowss(int r, int c0, float s) const { SSP[(size_t)r * 16 + (c0 >> 6)] = s; }
    __device__ __forceinline__ NoCtx row_ctx(int) const { return NoCtx{}; }
    __device__ __forceinline__ void vec8(const NoCtx&, int r, int c, f32x4 lo, f32x4 hi) const {
        if (c < 384) st_bf8(CQ + (size_t)r * 384 + c, lo, hi);
        else if (c < 640) st_bf8(CKV + (size_t)r * 256 + (c - 384), lo, hi);
        else if (c < 704) st_bf8(KR + (size_t)r * 64 + (c - 640), lo, hi);
        else if (c < 1728) { for (int j = 0; j < 4; ++j) { lo[j] = silu_fast(lo[j]); hi[j] = silu_fast(hi[j]); } st_bf8(MSG + (size_t)r * 1024 + (c - 704), lo, hi); }
    } };
struct VEpiRowScale { static constexpr bool HAS_PRE = false; static constexpr bool HAS_PRELOAD = false; struct PL {}; static constexpr bool HAS_ROPE = true, HAS_ROWSS = false; bf16_t* O; int ldo; const float* SSP; int t0, nt; float invk; int rope_mod;
    __device__ __forceinline__ bool rope_block(int c0) const { return rope_mod != 0 && (c0 % 192) == 128; }
    __device__ __forceinline__ bool rowss_block(int) const { return false; }
    __device__ __forceinline__ void rowss(int, int, float) const {}
    __device__ __forceinline__ float row_ctx(int r) const { float s = 0.f; for (int t = 0; t < nt; ++t) s += SSP[(size_t)r * 16 + t0 + t]; return 1.0f / sqrtf(s * invk + 1e-6f); }
    __device__ __forceinline__ void vec8(const float& rstd, int r, int c, f32x4 lo, f32x4 hi) const { for (int j = 0; j < 4; ++j) { lo[j] *= rstd; hi[j] *= rstd; } st_bf8(O + (size_t)r * ldo + c, lo, hi); } };

typedef short s16x4 __attribute__((ext_vector_type(4)));
typedef float f32x16 __attribute__((ext_vector_type(16)));
typedef unsigned u32x4 __attribute__((ext_vector_type(4)));
constexpr float ATT_SCALE = 0.07216878364870322f;
constexpr float ATT_THR = 8.f;
constexpr int SHM_V = 64 * 128 * 2, SHM_K = 64 * 128 * 2, SHM_R = 64 * 64 * 2;
#define KSWZ(row, colB) ((row) * 256 + ((colB) ^ (((row) & 15) << 4)))
#define RSWZF(row) ((((row) >> 1) & 3) | ((((row) >> 4) & 1) << 2))
#define RSWZ(row, colB) ((row) * 128 + ((colB) ^ (RSWZF(row) << 4)))
__device__ __forceinline__ int crow(int r, int hi) { return (r & 3) + 8 * (r >> 2) + 4 * hi; }
__device__ __forceinline__ unsigned cvtpk(float lo, float hi) { unsigned r; asm volatile("v_cvt_pk_bf16_f32 %0, %1, %2" : "=v"(r) : "v"(lo), "v"(hi)); return r; }
__device__ __forceinline__ void partialSM(f32x16& p0, f32x16& p1, float& m_reg, float& mn, float& alpha) {
    constexpr float C = ATT_SCALE * 1.4426950408889634f;
    float pmax = p0[0];
#pragma unroll
    for (int r = 1; r < 16; ++r) pmax = fmaxf(pmax, p0[r]);
#pragma unroll
    for (int r = 0; r < 16; ++r) pmax = fmaxf(pmax, p1[r]);
    { auto rr = __builtin_amdgcn_permlane32_swap(__float_as_uint(pmax), __float_as_uint(pmax), false, false);
      pmax = fmaxf(__uint_as_float(rr[0]), __uint_as_float(rr[1])); }
    if (__builtin_expect(__all(pmax - m_reg <= ATT_THR / ATT_SCALE), 1)) { mn = m_reg; alpha = 1.f; }
    else { mn = fmaxf(m_reg, pmax); alpha = __builtin_amdgcn_exp2f((m_reg - mn) * C); m_reg = mn; }
    float mnC = -mn * C;
#pragma unroll
    for (int r = 0; r < 16; ++r) p0[r] = fmaf(p0[r], C, mnC);
#pragma unroll
    for (int r = 0; r < 16; ++r) p1[r] = fmaf(p1[r], C, mnC);
#pragma unroll
    for (int r = 0; r < 16; ++r) p0[r] = __builtin_amdgcn_exp2f(p0[r]);
}
__device__ __forceinline__ void finishSM(f32x16& p0, f32x16& p1, float alpha, float& l_reg, bf16x8& pa0, bf16x8& pa1, bf16x8& pa2, bf16x8& pa3) {
#pragma unroll
    for (int r = 0; r < 16; ++r) p1[r] = __builtin_amdgcn_exp2f(p1[r]);
    float ps = 0;
#pragma unroll
    for (int r = 0; r < 16; ++r) ps += p0[r];
#pragma unroll
    for (int r = 0; r < 16; ++r) ps += p1[r];
    { auto rr = __builtin_amdgcn_permlane32_swap(__float_as_uint(ps), __float_as_uint(ps), false, false);
      ps = __uint_as_float(rr[0]) + __uint_as_float(rr[1]); }
    l_reg = l_reg * alpha + ps;
#define PK4(P, BASE, OUT) do { unsigned a0 = cvtpk(P[BASE + 0], P[BASE + 1]), a1 = cvtpk(P[BASE + 2], P[BASE + 3]);   \
    unsigned b0 = cvtpk(P[BASE + 4], P[BASE + 5]), b1 = cvtpk(P[BASE + 6], P[BASE + 7]);                              \
    auto r0 = __builtin_amdgcn_permlane32_swap(a0, b0, false, false); auto r1 = __builtin_amdgcn_permlane32_swap(a1, b1, false, false); \
    u32x4 w = {r0[0], r1[0], r0[1], r1[1]}; OUT = *reinterpret_cast<bf16x8*>(&w); } while (0)
    PK4(p0, 0, pa0); PK4(p0, 8, pa1); PK4(p1, 0, pa2); PK4(p1, 8, pa3);
#undef PK4
}
__device__ __forceinline__ int v_st(int k, int c) { const int kk = (k & ~0xC) | ((k & 4) << 1) | ((k & 8) >> 1); return ((kk >> 3) * 4 + (c >> 5)) * 512 + ((kk & 7) * 32 + (c & 31)) * 2; }
__device__ __forceinline__ int v_rd_base(int lane) { return ((lane & 3) << 3) | (((lane >> 2) & 3) << 6) | (((lane >> 4) & 1) << 5) | (((lane >> 5) & 1) << 8); }
constexpr int v_rd_off(int d0, int ks, int half) { return d0 * 512 + ks * 4096 + half * 2048; }
template <int OFF> __device__ __forceinline__ s16x4 tr_read(int vb) { s16x4 r; asm volatile("ds_read_b64_tr_b16 %0, %1 offset:%2" : "=&v"(r) : "v"(vb), "i"(OFF) : "memory"); return r; }
#define TRV(D0, KS, HF) tr_read<v_rd_off(D0, KS, HF)>(vb)
#define PKV(L, H) (bf16x8){L[0], L[1], L[2], L[3], H[0], H[1], H[2], H[3]}
__device__ __forceinline__ void pv_all(f32x16 (&o)[4], int vb, bf16x8 pa0, bf16x8 pa1, bf16x8 pa2, bf16x8 pa3) {
    s16x4 a0 = TRV(0, 0, 0), a1 = TRV(0, 0, 1), a2 = TRV(0, 1, 0), a3 = TRV(0, 1, 1), a4 = TRV(0, 2, 0), a5 = TRV(0, 2, 1), a6 = TRV(0, 3, 0), a7 = TRV(0, 3, 1);
    s16x4 b0 = TRV(1, 0, 0), b1 = TRV(1, 0, 1), b2 = TRV(1, 1, 0), b3 = TRV(1, 1, 1), b4 = TRV(1, 2, 0), b5 = TRV(1, 2, 1), b6 = TRV(1, 3, 0), b7 = TRV(1, 3, 1);
    asm volatile("s_waitcnt lgkmcnt(8)" ::: "memory"); SBAR();
    o[0] = __builtin_amdgcn_mfma_f32_32x32x16_bf16(pa0, PKV(a0, a1), o[0], 0, 0, 0); o[0] = __builtin_amdgcn_mfma_f32_32x32x16_bf16(pa1, PKV(a2, a3), o[0], 0, 0, 0);
    o[0] = __builtin_amdgcn_mfma_f32_32x32x16_bf16(pa2, PKV(a4, a5), o[0], 0, 0, 0); o[0] = __builtin_amdgcn_mfma_f32_32x32x16_bf16(pa3, PKV(a6, a7), o[0], 0, 0, 0);
    SBAR();
    a0 = TRV(2, 0, 0); a1 = TRV(2, 0, 1); a2 = TRV(2, 1, 0); a3 = TRV(2, 1, 1); a4 = TRV(2, 2, 0); a5 = TRV(2, 2, 1); a6 = TRV(2, 3, 0); a7 = TRV(2, 3, 1);
    asm volatile("s_waitcnt lgkmcnt(8)" ::: "memory"); SBAR();
    o[1] = __builtin_amdgcn_mfma_f32_32x32x16_bf16(pa0, PKV(b0, b1), o[1], 0, 0, 0); o[1] = __builtin_amdgcn_mfma_f32_32x32x16_bf16(pa1, PKV(b2, b3), o[1], 0, 0, 0);
    o[1] = __builtin_amdgcn_mfma_f32_32x32x16_bf16(pa2, PKV(b4, b5), o[1], 0, 0, 0); o[1] = __builtin_amdgcn_mfma_f32_32x32x16_bf16(pa3, PKV(b6, b7), o[1], 0, 0, 0);
    SBAR();
    b0 = TRV(3, 0, 0); b1 = TRV(3, 0, 1); b2 = TRV(3, 1, 0); b3 = TRV(3, 1, 1); b4 = TRV(3, 2, 0); b5 = TRV(3, 2, 1); b6 = TRV(3, 3, 0); b7 = TRV(3, 3, 1);
    asm volatile("s_waitcnt lgkmcnt(8)" ::: "memory"); SBAR();
    o[2] = __builtin_amdgcn_mfma_f32_32x32x16_bf16(pa0, PKV(a0, a1), o[2], 0, 0, 0); o[2] = __builtin_amdgcn_mfma_f32_32x32x16_bf16(pa1, PKV(a2, a3), o[2], 0, 0, 0);
    o[2] = __builtin_amdgcn_mfma_f32_32x32x16_bf16(pa2, PKV(a4, a5), o[2], 0, 0, 0); o[2] = __builtin_amdgcn_mfma_f32_32x32x16_bf16(pa3, PKV(a6, a7), o[2], 0, 0, 0);
    asm volatile("s_waitcnt lgkmcnt(0)" ::: "memory"); SBAR();
    o[3] = __builtin_amdgcn_mfma_f32_32x32x16_bf16(pa0, PKV(b0, b1), o[3], 0, 0, 0); o[3] = __builtin_amdgcn_mfma_f32_32x32x16_bf16(pa1, PKV(b2, b3), o[3], 0, 0, 0);
    o[3] = __builtin_amdgcn_mfma_f32_32x32x16_bf16(pa2, PKV(b4, b5), o[3], 0, 0, 0); o[3] = __builtin_amdgcn_mfma_f32_32x32x16_bf16(pa3, PKV(b6, b7), o[3], 0, 0, 0);
}
#undef TRV
#undef PKV
__device__ void attn_unit(const bf16_t* __restrict__ Qb, const bf16_t* __restrict__ Kn, const bf16_t* __restrict__ Vh, const bf16_t* __restrict__ Kr, bf16_t* Og, int nkeys, char* lds, int dry = 0) {
    int tid_ = threadIdx.x; asm volatile("" : "+v"(tid_)); const int tid = tid_, wid = tid >> 6, lane = tid & 63, r32 = lane & 31, hi = lane >> 5;
    char* V_lds = lds; char* K_lds = lds + 3 * SHM_V; char* R_lds = K_lds + 3 * SHM_K;
    float* wsx = (float*)(R_lds + 3 * SHM_R) + wid * 64; float* li_l = wsx; float* al_l = wsx + 32;
    float m_reg = -1e30f, l_reg = 0.f; f32x16 o[4];
#pragma unroll
    for (int d = 0; d < 4; ++d)
#pragma unroll
        for (int r = 0; r < 16; ++r) o[d][r] = 0.f;
    bf16x8 qr[12];
    { const bf16_t* Qw = Qb + (size_t)(wid * 32 + r32) * QW + hi * 8;
#pragma unroll
      for (int d0 = 0; d0 < 12; ++d0) qr[d0] = *(const bf16x8*)(Qw + d0 * 16); }
    int offK[2], offV[2], offR;
#pragma unroll
    for (int i = 0; i < 2; ++i) { int pc = 2 * wid + i; int row = 4 * pc + (lane >> 4); offK[i] = row * KVW + (((lane & 15) ^ (row & 15)) << 3);
        int L = pc * 1024 + lane * 16; int st = L >> 9, e = (L & 511) >> 1; int kk = (st >> 2) * 8 + (e >> 5), c = (st & 3) * 32 + (e & 31); int k = (kk & ~0xC) | ((kk & 4) << 1) | ((kk & 8) >> 1);
        offV[i] = k * KVW + c; }
    { int row = 8 * wid + (lane >> 3); offR = row * 64 + (((lane & 7) ^ RSWZF(row)) << 3); }
#define AT_ISSUE(t) do { const int b_ = (t) % 3; const size_t kb_ = (size_t)(t) * 64; \
        _Pragma("unroll") for (int i_ = 0; i_ < 2; ++i_) { \
            __builtin_amdgcn_global_load_lds((const unsigned*)(Kn + kb_ * KVW + offK[i_]), (__attribute__((address_space(3))) unsigned*)(K_lds + b_ * SHM_K + (2 * wid + i_) * 1024 + lane * 16), 16, 0, 0); \
            __builtin_amdgcn_global_load_lds((const unsigned*)(Vh + kb_ * KVW + offV[i_]), (__attribute__((address_space(3))) unsigned*)(V_lds + b_ * SHM_V + (2 * wid + i_) * 1024 + lane * 16), 16, 0, 0); } \
        __builtin_amdgcn_global_load_lds((const unsigned*)(Kr + kb_ * 64 + offR), (__attribute__((address_space(3))) unsigned*)(R_lds + b_ * SHM_R + wid * 1024 + lane * 16), 16, 0, 0); } while (0)
#define AT_BAR() do { asm volatile("" ::: "memory"); __builtin_amdgcn_s_barrier(); asm volatile("" ::: "memory"); } while (0)
    const int vb0 = (int)(uintptr_t)V_lds + v_rd_base(lane);
    const int NT = nkeys / 64;
    __syncthreads();
    const int lag = __builtin_amdgcn_readfirstlane(wid >> 2);
    AT_ISSUE(0); AT_ISSUE(1); AT_ISSUE(2);
    asm volatile("s_waitcnt vmcnt(10)" ::: "memory");
    AT_BAR();
    if (lag) AT_BAR();
    int bj = 0;
    for (int j = 0; j < NT; ++j) {
#define AT_TOP_ODD() do { if (j >= 1 && j + 2 < NT) AT_ISSUE(j + 2); } while (0)
#define AT_END_ODD() do { if (j + 1 < NT) { if (j + 2 < NT) asm volatile("s_waitcnt vmcnt(5)" ::: "memory"); else asm volatile("s_waitcnt vmcnt(0)" ::: "memory"); } } while (0)
        if (lag) AT_TOP_ODD();
        f32x16 p0, p1;
#pragma unroll
        for (int r = 0; r < 16; ++r) { p0[r] = 0.f; p1[r] = 0.f; }
        {
          const int kb0 = (int)(uintptr_t)(K_lds + bj * SHM_K) + r32 * 256 + ((hi ^ (r32 & 15)) << 4);
          const int rb0 = (int)(uintptr_t)(R_lds + bj * SHM_R) + r32 * 128 + ((hi ^ RSWZF(r32)) << 4);
#define KRD(dst, addr, OFF) asm volatile("ds_read_b128 %0, %1 offset:%2" : "=v"(dst) : "v"(addr), "i"(OFF) : "memory")
#define KADDR(d0_) ((d0_) < 8 ? (kb0 ^ ((d0_) << 5)) : (rb0 ^ (((d0_) - 8) << 5)))
#define KISSUE(A_, B_, d0_) do { const int ad_ = KADDR(d0_); if ((d0_) < 8) { KRD(A_, ad_, 0); KRD(B_, ad_, 8192); } else { KRD(A_, ad_, 0); KRD(B_, ad_, 4096); } } while (0)
          bf16x8 k0a, k0b, k1a, k1b;
          KISSUE(k0a, k0b, 0); KISSUE(k1a, k1b, 1);
#define QSTEP(A_, B_, d0_) do { \
              if ((d0_) <= 10) asm volatile("s_waitcnt lgkmcnt(2)" ::: "memory"); else asm volatile("s_waitcnt lgkmcnt(0)" ::: "memory"); \
              SBAR(); \
              p0 = __builtin_amdgcn_mfma_f32_32x32x16_bf16(A_, qr[(d0_)], p0, 0, 0, 0); p1 = __builtin_amdgcn_mfma_f32_32x32x16_bf16(B_, qr[(d0_)], p1, 0, 0, 0); \
              SBAR(); \
              if ((d0_) + 2 < 12) KISSUE(A_, B_, (d0_) + 2); } while (0)
          QSTEP(k0a, k0b, 0); QSTEP(k1a, k1b, 1); QSTEP(k0a, k0b, 2); QSTEP(k1a, k1b, 3); QSTEP(k0a, k0b, 4); QSTEP(k1a, k1b, 5);
          QSTEP(k0a, k0b, 6); QSTEP(k1a, k1b, 7); QSTEP(k0a, k0b, 8); QSTEP(k1a, k1b, 9); QSTEP(k0a, k0b, 10); QSTEP(k1a, k1b, 11);
#undef QSTEP
#undef KISSUE
#undef KADDR
#undef KRD
        }
        if (lag) AT_END_ODD();
        AT_BAR();
        if (!lag) AT_TOP_ODD();
        float mn, alpha;
        partialSM(p0, p1, m_reg, mn, alpha);
        if (__any(alpha < 1.f)) { if (hi == 0) al_l[r32] = alpha; asm volatile("s_waitcnt lgkmcnt(0)" ::: "memory");
#pragma unroll
            for (int d = 0; d < 4; ++d)
#pragma unroll
                for (int r = 0; r < 16; ++r) o[d][r] *= al_l[crow(r, hi)]; }
        bf16x8 pa0, pa1, pa2, pa3;
        finishSM(p0, p1, alpha, l_reg, pa0, pa1, pa2, pa3); SBAR();
        pv_all(o, vb0 + bj * SHM_V, pa0, pa1, pa2, pa3);
        if (!lag) AT_END_ODD();
        AT_BAR();
        bj = bj == 2 ? 0 : bj + 1;
    }
    if (!lag) AT_BAR();
#undef AT_TOP_ODD
#undef AT_END_ODD
#undef AT_ISSUE
#undef AT_BAR
    if (hi == 0) li_l[r32] = l_reg; asm volatile("s_waitcnt lgkmcnt(0)" ::: "memory");
    float rli[16];
#pragma unroll
    for (int r = 0; r < 16; ++r) rli[r] = 1.0f / li_l[crow(r, hi)];
    bf16_t* Ow = Og + (size_t)(wid * 32) * 1024;
    bf16_t gt[16][4];
#pragma unroll
    for (int r = 0; r < 16; ++r) { int orow = crow(r, hi);
#pragma unroll
        for (int d0 = 0; d0 < 4; ++d0) gt[r][d0] = __builtin_nontemporal_load(Ow + (size_t)orow * 1024 + d0 * 32 + r32); }
#pragma unroll
    for (int r = 0; r < 16; ++r) { int orow = crow(r, hi);
#pragma unroll
        for (int d0 = 0; d0 < 4; ++d0) { bf16_t* m = Ow + (size_t)orow * 1024 + d0 * 32 + r32; float val = o[d0][r] * rli[r] * bf2f(gt[r][d0]); if (!dry) *m = f2bf(val); else asm volatile("" :: "v"(val)); } }
}
__device__ void phase_attn(const Params& p, bool with_ctx, char* smem, bool dry = false) {
    char* ws = p.ws; const bf16_t* Q = (const bf16_t*)p.xout; const bf16_t* KV = (const bf16_t*)(ws + O_KV); const bf16_t* KR = (const bf16_t*)(ws + O_KR); bf16_t* MSG = (bf16_t*)(ws + O_MSG);
    const int h = blockIdx.x & 7, jw = blockIdx.x >> 3, nj = gridDim.x >> 3;
    const int nunits = 64 + (with_ctx ? 8 : 0);
    for (int lu = jw; lu < nunits; lu += nj) {
        int b, s0, nkeys;
        if (lu < 64) { b = lu >> 3; s0 = CTX + (lu & 7) * 256; nkeys = SALL; } else { b = lu - 64; s0 = 0; nkeys = CTX; }
        size_t rb = (size_t)b * SALL;
        attn_unit(Q + (rb + s0) * QW + h * 192, KV + rb * KVW + h * 256, KV + rb * KVW + h * 256 + 128, KR + rb * 64, MSG + (rb + s0) * 1024 + h * 128, nkeys, smem, dry);
    }
}


__device__ void phase_conv(const Params& p, int e) {
    int tid_ = threadIdx.x; asm volatile("" : "+v"(tid_)); const int tid = tid_;
    const bf16_t* XA = (const bf16_t*)p.xout; bf16_t* U = (bf16_t*)(p.ws + E_N);
    const float* cwp = p.in[8] + (size_t)e * 4 * 1024; const float* cbp = p.in[9] + e * 1024;
    const int gt = blockIdx.x * NTHR + tid, nthreads = gridDim.x * NTHR;
    const int c8 = (gt & 127) * 8; const int nruns = nthreads >> 7; const int rows_per = (NTOK + nruns - 1) / nruns;
    float w[4][8], bias[8];
#pragma unroll
    for (int k = 0; k < 4; ++k) { f32x4 w0 = *(const f32x4*)(cwp + k * 1024 + c8), w1 = *(const f32x4*)(cwp + k * 1024 + c8 + 4);
#pragma unroll
        for (int j = 0; j < 4; ++j) { w[k][j] = w0[j]; w[k][4 + j] = w1[j]; } }
    { f32x4 c0 = *(const f32x4*)(cbp + c8), c1 = *(const f32x4*)(cbp + c8 + 4);
#pragma unroll
      for (int j = 0; j < 4; ++j) { bias[j] = c0[j]; bias[4 + j] = c1[j]; } }
    const int r0 = (gt >> 7) * rows_per; const int r1 = (r0 + rows_per < NTOK) ? r0 + rows_per : NTOK;
    for (int rg = r0; rg < r1; rg += 6) {
        uint4 xv[9];
#pragma unroll
        for (int i = 0; i < 9; ++i) { int rr = rg - 2 + i; rr = rr < 0 ? 0 : (rr >= NTOK ? NTOK - 1 : rr); xv[i] = *(const uint4*)(XA + (size_t)rr * 1024 + c8); }
#pragma unroll
        for (int o6 = 0; o6 < 6; ++o6) { const int r = rg + o6; if (r >= r1) break;
            int b = r / SALL, s = r - b * SALL; int qlo = s < CTX ? 0 : CTX, qhi = s < CTX ? CTX : SALL;
            float acc[8];
#pragma unroll
            for (int j = 0; j < 8; ++j) acc[j] = bias[j];
#pragma unroll
            for (int k = 0; k < 4; ++k) { int s2 = s + k - 2; const uint4 x = xv[o6 + k]; const float m = (s2 >= qlo && s2 < qhi) ? 1.f : 0.f;
                acc[0] += m * w[k][0] * __uint_as_float(x.x << 16); acc[1] += m * w[k][1] * __uint_as_float(x.x & 0xffff0000u); acc[2] += m * w[k][2] * __uint_as_float(x.y << 16); acc[3] += m * w[k][3] * __uint_as_float(x.y & 0xffff0000u);
                acc[4] += m * w[k][4] * __uint_as_float(x.z << 16); acc[5] += m * w[k][5] * __uint_as_float(x.z & 0xffff0000u); acc[6] += m * w[k][6] * __uint_as_float(x.w << 16); acc[7] += m * w[k][7] * __uint_as_float(x.w & 0xffff0000u); }
            uint4 o; o.x = cvtpk(acc[0], acc[1]); o.y = cvtpk(acc[2], acc[3]); o.z = cvtpk(acc[4], acc[5]); o.w = cvtpk(acc[6], acc[7]);
            *(uint4*)(U + (size_t)r * 1024 + c8) = o; } }
}
template <int CTRL> __device__ __forceinline__ float dpp_f(float v, float ident) { return __int_as_float(__builtin_amdgcn_update_dpp(__float_as_int(ident), __float_as_int(v), CTRL, 0xf, 0xf, false)); }
constexpr int LRU_TOK = 128, LRU_D = 2, LRU_R = 3, LRU_SLOT = 49152, LRU_NS = SALL / LRU_TOK;
constexpr int LRU_TOT = LRU_R * LRU_SLOT;
constexpr int LRU_CAR = LRU_TOT + 4 * 8 * 4 * 2 * 8;
static_assert(LRU_CAR + 2 * 4 * 4 * 2 * 4 <= SMEM_BYTES - 16, "lru lds");
__device__ __forceinline__ int lru_chain_s(int d, int i) { return d == 0 ? i : (i < CTX ? CTX - 1 - i : SALL - 1 - (i - CTX)); }
__device__ void lru_item(const Params& p, int e, int b, int h, int q4, char* lds, int dry) {
    int tid_ = threadIdx.x; asm volatile("" : "+v"(tid_)); const int tid = tid_;
    const int wid = __builtin_amdgcn_readfirstlane(tid >> 6), lane = tid & 63, fr = lane & 15, fq = lane >> 4;
    char* ws = p.ws;
    const bf16_t* U = (const bf16_t*)(ws + E_N); bf16_t* HF = (bf16_t*)p.xout; bf16_t* MRG = (bf16_t*)(ws + E_MRG);
    const bf16_t* WL = (const bf16_t*)(ws + OFF_WBF) + e * WE_SZ + WE_LRU + (size_t)h * 512 * 128;
    const size_t rb = (size_t)b * SALL;
    const bool loader = wid >= 4; const int lw = wid & 3, th = wid >> 2;
    const int c8 = q4 * 32 + lw * 8;
    const int che = (fq & 1) * 4 + (fq >> 1) * 2;
    const int chg = h * 128 + c8 + che;
    float2* TOT = (float2*)(lds + LRU_TOT) + lw * 64;
    float* CAR = (float*)(lds + LRU_CAR) + lw * 8;
    for (int d = 0; d < 2; ++d) {
        bf16x8 wfr[4]; f32x4 binit; float sp8[2];
        { int gate = fr >> 3; const bf16_t* wrow = WL + (size_t)((d * 2 + gate) * 128 + c8 + (fr & 7)) * 128 + fq * 8;
#pragma unroll
          for (int ks = 0; ks < 4; ++ks) wfr[ks] = *(const bf16x8*)(wrow + ks * 32);
          const float* bp = p.in[fq < 2 ? 11 : 13] + (e * 2 + d) * 1024 + h * 128 + c8 + (fq & 1) * 4;
#pragma unroll
          for (int j = 0; j < 4; ++j) binit[j] = -1.4426950408889634f * bp[j];
#pragma unroll
          for (int j = 0; j < 2; ++j) { float lam = p.in[14][(e * 2 + d) * 1024 + chg + j]; sp8[j] = -8.f * log1pf(expf(-lam)) * 1.4426950408889634f; } }
        if (fr == 15) { CAR[fq * 2] = 0.f; CAR[fq * 2 + 1] = 0.f; }
#define LRU_ISSUE(s_) do { char* slot_ = lds + ((s_) % LRU_R) * LRU_SLOT; \
            _Pragma("unroll") for (int i_ = 0; i_ < 4; ++i_) { int trow_ = 16 * wid + 4 * i_ + (lane >> 4); size_t grow_ = rb + lru_chain_s(d, (s_) * LRU_TOK + trow_); \
                __builtin_amdgcn_global_load_lds((const unsigned*)(U + grow_ * 1024 + h * 128 + (((lane & 15) ^ (trow_ & 15)) << 3)), (__attribute__((address_space(3))) unsigned*)(slot_ + (4 * wid + i_) * 1024 + lane * 16), 16, 0, 0); } \
            if (d == 1) { size_t gr2_ = rb + lru_chain_s(d, (s_) * LRU_TOK + 16 * wid + (lane >> 2)); \
                __builtin_amdgcn_global_load_lds((const unsigned*)(HF + gr2_ * 1024 + h * 128 + q4 * 32 + (lane & 3) * 8), (__attribute__((address_space(3))) unsigned*)(slot_ + 32768 + wid * 1024 + lane * 16), 16, 0, 16); \
                __builtin_amdgcn_global_load_lds((const unsigned*)(MRG + gr2_ * 1536 + h * 128 + q4 * 32 + (lane & 3) * 8), (__attribute__((address_space(3))) unsigned*)(slot_ + 40960 + wid * 1024 + lane * 16), 16, 0, 0); } } while (0)
#define LRU_WAIT() do { if (d == 1) asm volatile("s_waitcnt vmcnt(6)" ::: "memory"); else asm volatile("s_waitcnt vmcnt(4)" ::: "memory"); } while (0)
        { for (int s = 0; s < LRU_D; ++s) LRU_ISSUE(s); LRU_WAIT(); }
        asm volatile("" ::: "memory"); __builtin_amdgcn_s_barrier(); asm volatile("" ::: "memory");
        for (int k = 0; k < LRU_NS; ++k) {
            if (k + LRU_D < LRU_NS && dry != 2) LRU_ISSUE(k + LRU_D);
            const char* slot = lds + (k % LRU_R) * LRU_SLOT;
            float av[4][2], bv[4][2]; unsigned hfv[4], gv[4];
            if (dry >= 10) {
#pragma unroll
                for (int mi = 0; mi < 4; ++mi) { av[mi][0] = 0.5f; av[mi][1] = 0.5f; bv[mi][0] = 1.f; bv[mi][1] = 1.f; hfv[mi] = 0u; gv[mi] = 0u; } }
            else {
#pragma unroll
            for (int mi = 0; mi < 4; ++mi) { const int mf = 4 * th + mi; const char* rowp = slot + (16 * mf + fr) * 256;
                bf16x8 af0 = *(const bf16x8*)(rowp + (((0 + fq) ^ fr) << 4)), af1 = *(const bf16x8*)(rowp + (((4 + fq) ^ fr) << 4));
                bf16x8 af2 = *(const bf16x8*)(rowp + (((8 + fq) ^ fr) << 4)), af3 = *(const bf16x8*)(rowp + (((12 + fq) ^ fr) << 4));
                const unsigned cu2 = *(const unsigned*)(rowp + (((c8 >> 3) ^ fr) << 4) + che * 2);
                hfv[mi] = 0u; gv[mi] = 0u;
                if (d == 1) { hfv[mi] = *(const unsigned*)(slot + 32768 + (16 * mf + fr) * 64 + (lw * 8 + che) * 2); gv[mi] = *(const unsigned*)(slot + 40960 + (16 * mf + fr) * 64 + (lw * 8 + che) * 2); }
                f32x4 acc = binit;
                acc = __builtin_amdgcn_mfma_f32_16x16x32_bf16(wfr[0], af0, acc, 0, 0, 0);
                acc = __builtin_amdgcn_mfma_f32_16x16x32_bf16(wfr[1], af1, acc, 0, 0, 0);
                acc = __builtin_amdgcn_mfma_f32_16x16x32_bf16(wfr[2], af2, acc, 0, 0, 0);
                acc = __builtin_amdgcn_mfma_f32_16x16x32_bf16(wfr[3], af3, acc, 0, 0, 0);
                auto s0 = __builtin_amdgcn_permlane32_swap(__float_as_uint(acc[0]), __float_as_uint(acc[2]), false, false);
                auto s1 = __builtin_amdgcn_permlane32_swap(__float_as_uint(acc[1]), __float_as_uint(acc[3]), false, false);
                float zr0 = __uint_as_float(s0[0]), zi0 = __uint_as_float(s0[1]), zr1 = __uint_as_float(s1[0]), zi1 = __uint_as_float(s1[1]);
                float r0 = __builtin_amdgcn_rcpf(1.f + __builtin_amdgcn_exp2f(zr0)), i0 = __builtin_amdgcn_rcpf(1.f + __builtin_amdgcn_exp2f(zi0));
                float r1 = __builtin_amdgcn_rcpf(1.f + __builtin_amdgcn_exp2f(zr1)), i1 = __builtin_amdgcn_rcpf(1.f + __builtin_amdgcn_exp2f(zi1));
                float a0 = __builtin_amdgcn_exp2f(r0 * sp8[0]), a1 = __builtin_amdgcn_exp2f(r1 * sp8[1]);
                av[mi][0] = a0; av[mi][1] = a1;
                bv[mi][0] = __builtin_amdgcn_sqrtf(fmaf(-a0, a0, 1.f)) * (i0 * __uint_as_float(cu2 << 16));
                bv[mi][1] = __builtin_amdgcn_sqrtf(fmaf(-a1, a1, 1.f)) * (i1 * __uint_as_float(cu2 & 0xffff0000u)); }
#define LRU_SCAN(N) asm volatile("s_nop 1\n\t" \
                "v_fmac_f32_dpp %0, %0, %8 row_shr:" #N " row_mask:0xf bank_mask:0xf\n\tv_fmac_f32_dpp %1, %1, %9 row_shr:" #N " row_mask:0xf bank_mask:0xf\n\t" \
                "v_fmac_f32_dpp %2, %2, %10 row_shr:" #N " row_mask:0xf bank_mask:0xf\n\tv_fmac_f32_dpp %3, %3, %11 row_shr:" #N " row_mask:0xf bank_mask:0xf\n\t" \
                "v_fmac_f32_dpp %4, %4, %12 row_shr:" #N " row_mask:0xf bank_mask:0xf\n\tv_fmac_f32_dpp %5, %5, %13 row_shr:" #N " row_mask:0xf bank_mask:0xf\n\t" \
                "v_fmac_f32_dpp %6, %6, %14 row_shr:" #N " row_mask:0xf bank_mask:0xf\n\tv_fmac_f32_dpp %7, %7, %15 row_shr:" #N " row_mask:0xf bank_mask:0xf\n\t" \
                "v_mul_f32_dpp %8, %8, %8 row_shr:" #N " row_mask:0xf bank_mask:0xf\n\tv_mul_f32_dpp %9, %9, %9 row_shr:" #N " row_mask:0xf bank_mask:0xf\n\t" \
                "v_mul_f32_dpp %10, %10, %10 row_shr:" #N " row_mask:0xf bank_mask:0xf\n\tv_mul_f32_dpp %11, %11, %11 row_shr:" #N " row_mask:0xf bank_mask:0xf\n\t" \
                "v_mul_f32_dpp %12, %12, %12 row_shr:" #N " row_mask:0xf bank_mask:0xf\n\tv_mul_f32_dpp %13, %13, %13 row_shr:" #N " row_mask:0xf bank_mask:0xf\n\t" \
                "v_mul_f32_dpp %14, %14, %14 row_shr:" #N " row_mask:0xf bank_mask:0xf\n\tv_mul_f32_dpp %15, %15, %15 row_shr:" #N " row_mask:0xf bank_mask:0xf\n\ts_nop 1" \
                : "+v"(bv[0][0]), "+v"(bv[0][1]), "+v"(bv[1][0]), "+v"(bv[1][1]), "+v"(bv[2][0]), "+v"(bv[2][1]), "+v"(bv[3][0]), "+v"(bv[3][1]), \
                  "+v"(av[0][0]), "+v"(av[0][1]), "+v"(av[1][0]), "+v"(av[1][1]), "+v"(av[2][0]), "+v"(av[2][1]), "+v"(av[3][0]), "+v"(av[3][1]))
            LRU_SCAN(1); LRU_SCAN(2); LRU_SCAN(4); LRU_SCAN(8);
            }
#undef LRU_SCAN
            if (fr == 15 && dry != 11) {
#pragma unroll
                for (int mi = 0; mi < 4; ++mi) { TOT[((4 * th + mi) * 4 + fq) * 2 + 0] = make_float2(av[mi][0], bv[mi][0]); TOT[((4 * th + mi) * 4 + fq) * 2 + 1] = make_float2(av[mi][1], bv[mi][1]); } }
            if (k + LRU_D < LRU_NS) LRU_WAIT(); else asm volatile("s_waitcnt vmcnt(0)" ::: "memory");
            asm volatile("s_waitcnt lgkmcnt(0)" ::: "memory");
            asm volatile("" ::: "memory"); __builtin_amdgcn_s_barrier(); asm volatile("" ::: "memory");
            float hin0 = CAR[(k & 1) * 32 + fq * 2], hin1 = CAR[(k & 1) * 32 + fq * 2 + 1];
            for (int sg = 0; sg < 4 * th; ++sg) { float2 t0 = TOT[(sg * 4 + fq) * 2], t1 = TOT[(sg * 4 + fq) * 2 + 1]; hin0 = fmaf(t0.x, hin0, t0.y); hin1 = fmaf(t1.x, hin1, t1.y); }
            const size_t crow0 = rb + lru_chain_s(d, k * LRU_TOK + 64 * th + fr); const long dstep = (d == 0 ? 16 : -16);
#pragma unroll
            for (int mi = 0; mi < 4; ++mi) {
                float h0 = fmaf(av[mi][0], hin0, bv[mi][0]), h1 = fmaf(av[mi][1], hin1, bv[mi][1]);
                { float2 t0 = TOT[((4 * th + mi) * 4 + fq) * 2], t1 = TOT[((4 * th + mi) * 4 + fq) * 2 + 1]; hin0 = fmaf(t0.x, hin0, t0.y); hin1 = fmaf(t1.x, hin1, t1.y); }
                const size_t crow = crow0 + mi * dstep;
                if (d == 0) { if (dry != 4 && dry != 11) *(unsigned*)(HF + crow * 1024 + chg) = cvtpk(h0, h1); else asm volatile("" :: "v"(h0), "v"(h1)); }
                else { float y0 = (h0 + __uint_as_float(hfv[mi] << 16)) * __uint_as_float(gv[mi] << 16), y1 = (h1 + __uint_as_float(hfv[mi] & 0xffff0000u)) * __uint_as_float(gv[mi] & 0xffff0000u);
                    if (dry == 0) *(unsigned*)(MRG + crow * 1536 + chg) = cvtpk(y0, y1); else asm volatile("" :: "v"(y0), "v"(y1)); } }
            if (th == 1 && fr == 15) { CAR[((k + 1) & 1) * 32 + fq * 2] = hin0; CAR[((k + 1) & 1) * 32 + fq * 2 + 1] = hin1; }
            asm volatile("s_waitcnt lgkmcnt(0)" ::: "memory");
            asm volatile("" ::: "memory"); __builtin_amdgcn_s_barrier(); asm volatile("" ::: "memory");
        }
#undef LRU_ISSUE
#undef LRU_WAIT
        asm volatile("s_waitcnt vmcnt(0)" ::: "memory");
        asm volatile("" ::: "memory"); __builtin_amdgcn_s_barrier(); asm volatile("" ::: "memory");
    }
}
__device__ void phase_lru(const Params& p, int e, char* smem, int dry = 0) {
    __syncthreads();
    const int xcd = blockIdx.x & 7, j = blockIdx.x >> 3, nj = gridDim.x >> 3;
    for (int q = j; q < 32; q += nj) { int pair = xcd * 8 + (q >> 2); lru_item(p, e, pair >> 3, pair & 7, q & 3, smem, dry); }
}

constexpr size_t T_MM = 0, T_NM = 8388608, T_KS = 16777216, T_AP = T_KS + 1032192;
static_assert(T_AP + 32768 <= SZ_TAB, "tab");
__device__ void phase_s5_tables(const Params& p, int e, char* smem) {
    int tid_ = threadIdx.x; asm volatile("" : "+v"(tid_)); const int tid = tid_;
    float2* pw = (float2*)smem;
    float2* bb = pw + 33 * 64;
    float2* cc = bb + 64 * 16;
    float* k0 = (float*)(cc + 16 * 64);
    bf16_t* MM = (bf16_t*)(p.ws + OFF_TAB + T_MM); bf16_t* NM = (bf16_t*)(p.ws + OFF_TAB + T_NM); bf16_t* KS = (bf16_t*)(p.ws + OFF_TAB + T_KS); float2* AP = (float2*)(p.ws + OFF_TAB + T_AP);
    for (int it = blockIdx.x; it < 32 * 8; it += gridDim.x) { const int g = it >> 3, part = it & 7;
        for (int d = 0; d < 2; ++d) {
            __syncthreads();
            if (tid < 64) { int pp = tid; size_t gp = ((size_t)(e * 2 + d) * 32 + g) * 64 + pp;
                float lre = p.in[15][gp], lim = p.in[16][gp], dt = expf(p.in[17][gp]);
                float mag = expf(lre * dt), are = mag * cosf(lim * dt), aim = mag * sinf(lim * dt);
                float den = lre * lre + lim * lim, nr = are - 1.f;
                float fre = (nr * lre + aim * lim) / den, fim = (aim * lre - nr * lim) / den;
                for (int hh = 0; hh < 16; ++hh) { float br = p.in[18][gp * 16 + hh], bi = p.in[19][gp * 16 + hh]; bb[pp * 16 + hh] = make_float2(fre * br - fim * bi, fre * bi + fim * br); }
                double ar = are, ai = aim, pr = 1.0, pi = 0.0;
                for (int n = 0; n <= 32; ++n) { pw[n * 64 + pp] = make_float2((float)pr, (float)pi); double t = pr * ar - pi * ai; pi = pr * ai + pi * ar; pr = t; }
                if (part == 0) AP[(g * 2 + d) * 64 + pp] = pw[32 * 64 + pp]; }
            for (int i = tid; i < 1024; i += NTHR) { size_t ci = (((size_t)(e * 2 + d) * 32 + g) * 16) * 64 + i; cc[i] = make_float2(p.in[20][ci], p.in[21][ci]); }
            __syncthreads();
            bf16_t* mm = MM + (size_t)(g * 2 + d) * 128 * 512;
            for (int i = part * 8192 + tid; i < part * 8192 + 8192; i += NTHR) { int n = i >> 9, k = i & 511, pp = n & 63, im = n >> 6, tau = k >> 4, hh = k & 15;
                float2 w = d == 0 ? pw[(31 - tau) * 64 + pp] : pw[tau * 64 + pp]; float2 b2 = bb[pp * 16 + hh];
                float v = im ? (w.x * b2.y + w.y * b2.x) : (w.x * b2.x - w.y * b2.y); mm[i] = f2bf(v); }
            for (int i = part * 8192 + tid; i < part * 8192 + 8192; i += NTHR) { int n = i >> 7, kk = i & 127, tau = n >> 4, hh = n & 15, pp = kk & 63, im = kk >> 6;
                float2 w = d == 0 ? pw[(tau + 1) * 64 + pp] : pw[(32 - tau) * 64 + pp]; float2 c2 = cc[hh * 64 + pp];
                float zr = c2.x * w.x - c2.y * w.y, zi = c2.x * w.y + c2.y * w.x; NM[((size_t)g * 512 + n) * 256 + d * 128 + kk] = f2bf(im ? -zi : zr); }
            for (int i = part * 1024 + tid; i < part * 1024 + 1024; i += NTHR) { int lag = i >> 8, ho = (i >> 4) & 15, hi_ = i & 15; float s = 0.f;
                for (int pp = 0; pp < 64; ++pp) { float2 c2 = cc[ho * 64 + pp], w = pw[lag * 64 + pp], b2 = bb[pp * 16 + hi_]; float zr = c2.x * w.x - c2.y * w.y, zi = c2.x * w.y + c2.y * w.x; s += zr * b2.x - zi * b2.y; }
                if (lag == 0) { if (d == 0) k0[i] = s + (ho == hi_ ? p.in[22][(e * 32 + g) * 16 + ho] : 0.f); else KS[((size_t)g * 63 + 31) * 256 + i] = f2bf(k0[i] + s); }
                else { int di = d == 0 ? 31 + lag : 31 - lag; KS[((size_t)g * 63 + di) * 256 + (i & 255)] = f2bf(s); } }
        }
    }
}
__device__ void phase_s5a(const Params& p, char* smem) {
    int tid_ = threadIdx.x; asm volatile("" : "+v"(tid_)); const int tid = tid_, wid = tid >> 6, lane = tid & 63, fr = lane & 15, fq = lane >> 4;
    const bf16_t* UB = (const bf16_t*)(p.ws + E_UB); const bf16_t* MM = (const bf16_t*)(p.ws + OFF_TAB + T_MM); float* F = (float*)(p.ws + E_F);
    for (int it = blockIdx.x; it < 32 * 9; it += gridDim.x) { int g = it / 9, mt = it % 9; int d = wid >> 2;
        int R = mt * 64 + (wid & 3) * 16 + fr, b = R / 72, c = R % 72; size_t tok0 = (size_t)b * SALL + c * 32;
        f32x4 acc[8];
#pragma unroll
        for (int nf = 0; nf < 8; ++nf) acc[nf] = (f32x4){0.f, 0.f, 0.f, 0.f};
        const bf16_t* ub = UB + (tok0 + (fq >> 1)) * 512 + g * 16 + (fq & 1) * 8; const bf16_t* mm = MM + ((size_t)(g * 2 + d) * 128 + fr) * 512 + fq * 8;
#pragma unroll 2
        for (int ks = 0; ks < 16; ++ks) { bf16x8 af = *(const bf16x8*)(ub + (size_t)(2 * ks) * 512);
#pragma unroll
            for (int nf = 0; nf < 8; ++nf) { bf16x8 wf = *(const bf16x8*)(mm + (size_t)(nf * 16) * 512 + ks * 32); acc[nf] = __builtin_amdgcn_mfma_f32_16x16x32_bf16(wf, af, acc[nf], 0, 0, 0); } }
        float* fo = F + ((((size_t)b * 72 + c) * 32 + g) * 2 + d) * 128 + fq * 4;
#pragma unroll
        for (int nf = 0; nf < 8; ++nf) *(f32x4*)(fo + nf * 16) = acc[nf];
    }
}
constexpr int UL_STRIDE = 1040, HL_STRIDE = 528, L_HL = 80 * UL_STRIDE, L_S5B_END = L_HL + 80 * HL_STRIDE;
__device__ __forceinline__ float gelu_fast(float x) { float z = 0.7978845608028654f * (x + 0.044715f * x * x * x); return x * __builtin_amdgcn_rcpf(1.f + __builtin_amdgcn_exp2f(-2.f * 1.4426950408889634f * z)); }
__device__ void phase_s5b(const Params& p, char* smem) {
    int tid_ = threadIdx.x; asm volatile("" : "+v"(tid_)); const int tid = tid_, wid = tid >> 6, lane = tid & 63, fr = lane & 15, fq = lane >> 4;
    const bf16_t* UB = (const bf16_t*)(p.ws + E_UB); const bf16_t* NM = (const bf16_t*)(p.ws + OFF_TAB + T_NM); const bf16_t* KS = (const bf16_t*)(p.ws + OFF_TAB + T_KS);
    const float2* AP = (const float2*)(p.ws + OFF_TAB + T_AP); const float* F = (const float*)(p.ws + E_F); bf16_t* YB = (bf16_t*)(p.ws + E_YB);
    char* UL = smem; char* HL = smem + L_HL; float* FS = (float*)smem;
    for (int it = blockIdx.x; it < NB * 32; it += gridDim.x) { int b = it >> 5, g = it & 31;
        __syncthreads();
        for (int r = 0; r < 9; ++r) { int c = r * 8 + (tid >> 6); *(f32x4*)(FS + c * 256 + (tid & 63) * 4) = *(const f32x4*)(F + (((size_t)b * 72 + c) * 32 + g) * 256 + (tid & 63) * 4); }
        for (int i = tid; i < 8 * HL_STRIDE / 4; i += NTHR) ((unsigned*)(HL + 72 * HL_STRIDE))[i] = 0u;
        __syncthreads();
        if (tid < 128) { int d = tid >> 6, pp = tid & 63; float2 a32 = AP[(g * 2 + d) * 64 + pp]; float hr = 0.f, hi = 0.f;
            for (int i = 0; i < 72; ++i) { int c = d == 0 ? i : (i < 8 ? 7 - i : 79 - i);
                *(bf16_t*)(HL + c * HL_STRIDE + (d * 128 + pp) * 2) = f2bf(hr); *(bf16_t*)(HL + c * HL_STRIDE + (d * 128 + 64 + pp) * 2) = f2bf(hi);
                float fr_ = FS[c * 256 + d * 128 + pp], fi_ = FS[c * 256 + d * 128 + 64 + pp];
                float t = a32.x * hr - a32.y * hi + fr_; hi = a32.x * hi + a32.y * hr + fi_; hr = t; } }
        __syncthreads();
        for (int i = 0; i < 9; ++i) { int q = tid + 512 * i; int tok = q >> 1, half = q & 1; int c = tok >> 5, tau = tok & 31;
            *(uint4*)(UL + c * UL_STRIDE + (tau * 16 + half * 8) * 2) = *(const uint4*)(UB + ((size_t)b * SALL + tok) * 512 + g * 16 + half * 8); }
        for (int i = tid; i < 8 * UL_STRIDE / 4; i += NTHR) ((unsigned*)(UL + 72 * UL_STRIDE))[i] = 0u;
        __syncthreads();
        f32x4 acc[5][4];
#pragma unroll
        for (int mf = 0; mf < 5; ++mf)
#pragma unroll
            for (int nf = 0; nf < 4; ++nf) acc[mf][nf] = (f32x4){0.f, 0.f, 0.f, 0.f};
#pragma unroll 2
        for (int ks = 0; ks < 16; ++ks) { bf16x8 wf[4]; int tin = 2 * ks + (fq >> 1);
#pragma unroll
            for (int nf = 0; nf < 4; ++nf) { int delta = (4 * wid + nf) - tin + 31; wf[nf] = *(const bf16x8*)(KS + (((size_t)g * 63 + delta) * 16 + fr) * 16 + (fq & 1) * 8); }
#pragma unroll
            for (int mf = 0; mf < 5; ++mf) { bf16x8 af = *(const bf16x8*)(UL + (mf * 16 + fr) * UL_STRIDE + (ks * 32 + fq * 8) * 2);
#pragma unroll
                for (int nf = 0; nf < 4; ++nf) acc[mf][nf] = __builtin_amdgcn_mfma_f32_16x16x32_bf16(wf[nf], af, acc[mf][nf], 0, 0, 0); } }
#pragma unroll 2
        for (int ks = 0; ks < 8; ++ks) { bf16x8 wf[4];
#pragma unroll
            for (int nf = 0; nf < 4; ++nf) wf[nf] = *(const bf16x8*)(NM + ((size_t)g * 512 + (4 * wid + nf) * 16 + fr) * 256 + ks * 32 + fq * 8);
#pragma unroll
            for (int mf = 0; mf < 5; ++mf) { bf16x8 af = *(const bf16x8*)(HL + (mf * 16 + fr) * HL_STRIDE + (ks * 32 + fq * 8) * 2);
#pragma unroll
                for (int nf = 0; nf < 4; ++nf) acc[mf][nf] = __builtin_amdgcn_mfma_f32_16x16x32_bf16(wf[nf], af, acc[mf][nf], 0, 0, 0); } }
#pragma unroll
        for (int mf = 0; mf < 5; ++mf) { int c = mf * 16 + fr; if (c < 72) {
#pragma unroll
            for (int nf = 0; nf < 4; ++nf) { f32x4 v = acc[mf][nf];
#pragma unroll
                for (int j = 0; j < 4; ++j) v[j] = gelu_fast(v[j]);
                st_bf4(YB + ((size_t)b * SALL + c * 32 + 4 * wid + nf) * 512 + g * 16 + fq * 4, v); } } }
    }
}

__device__ void phase_mod(const Params& p, char* smem) {
    int tid_ = threadIdx.x; asm volatile("" : "+v"(tid_)); const int tid = tid_, wid = tid >> 6, lane = tid & 63;
    float* sc = (float*)smem;
    float* red = sc + 9 * 1024;
    __syncthreads();
    for (int i = tid; i < 9 * 1024; i += NTHR) { int r = i >> 10, k = i & 1023; float v = r < 8 ? p.in[1][r * 1024 + k] : p.in[3][k]; sc[i] = silu_f(v); }
    __syncthreads();
    for (int unit = blockIdx.x; unit < 4 * 48; unit += gridDim.x) { int l = unit / 48, cg = unit % 48, col = cg * 64 + lane;
        const float* W = p.in[5] + (size_t)l * 1024 * 3072 + col; float acc[9];
#pragma unroll
        for (int r = 0; r < 9; ++r) acc[r] = 0.f;
        for (int k0 = wid * 128; k0 < wid * 128 + 128; k0 += 16) { float wv[16];
#pragma unroll
            for (int i = 0; i < 16; ++i) wv[i] = W[(size_t)(k0 + i) * 3072];
#pragma unroll
            for (int i = 0; i < 16; ++i)
#pragma unroll
                for (int r = 0; r < 9; ++r) acc[r] += sc[r * 1024 + k0 + i] * wv[i]; }
#pragma unroll
        for (int r = 0; r < 9; ++r) red[(wid * 9 + r) * 64 + lane] = acc[r];
        __syncthreads();
        for (int i = tid; i < 9 * 64; i += NTHR) { int r = i >> 6, c = i & 63; float s = 0.f; for (int w = 0; w < 8; ++w) s += red[(w * 9 + r) * 64 + c];
            ((float*)(p.ws + OFF_MOD))[((size_t)l * 9 + r) * 3072 + cg * 64 + c] = s + p.in[6][l * 3072 + cg * 64 + c]; }
        __syncthreads();
    }
}
__device__ void phase_norm0(const Params& p, bf16_t* N) {
    int tid_ = threadIdx.x; asm volatile("" : "+v"(tid_)); const int tid = tid_, wid = tid >> 6, lane = tid & 63;
    const float* g = p.in[4]; float* SSX = (float*)(p.ws + OFF_SSX);
    for (int it = blockIdx.x; it < NTOK / 8; it += gridDim.x) { int r = it * 8 + wid; int b = r / SALL, s = r - b * SALL;
        bf16_t* xr = resid_row(p, r);
        const float* src = (s < CTX ? p.in[2] + (size_t)(b * CTX + s) * D : p.in[0] + (size_t)(b * SEQ + (s - CTX)) * D);
        const float* mod = (const float*)(p.ws + OFF_MOD) + (size_t)(s < CTX ? 8 : b) * 3072;
        f32x4 v[4]; float ss = 0.f;
#pragma unroll
        for (int i = 0; i < 4; ++i) { v[i] = *(const f32x4*)(src + lane * 4 + 256 * i); ss += v[i][0] * v[i][0] + v[i][1] * v[i][1] + v[i][2] * v[i][2] + v[i][3] * v[i][3]; }
#pragma unroll
        for (int o = 32; o; o >>= 1) ss += __shfl_xor(ss, o);
        if (lane < 16) SSX[(size_t)r * 16 + lane] = lane == 0 ? ss : 0.f;
#pragma unroll
        for (int i = 0; i < 4; ++i) { int k = lane * 4 + 256 * i; st_bf4(xr + k, v[i]);
            f32x4 gg = *(const f32x4*)(g + k), sc = *(const f32x4*)(mod + 1024 + k); f32x4 y;
#pragma unroll
            for (int j = 0; j < 4; ++j) y[j] = v[i][j] * gg[j] * (1.f + sc[j]);
            st_bf4(N + (size_t)r * 1024 + k, y); }
    }
}
__device__ void phase_shw(const Params& p) {
    int tid_ = threadIdx.x; asm volatile("" : "+v"(tid_)); const int tid = tid_, wid = tid >> 6, lane = tid & 63;
    const float* MOD = (const float*)(p.ws + OFF_MOD); float* SHW = (float*)(p.ws + OFF_SHW); float* GM = (float*)(p.ws + OFF_GM); const bf16_t* wb = (const bf16_t*)(p.ws + OFF_WBF);
    for (int i = blockIdx.x * NTHR + tid; i < 4 * 9 * 1024; i += gridDim.x * NTHR) { int l = i / 9216, r = (i / 1024) % 9, k = i & 1023; GM[i] = p.in[4][l * 1024 + k] * (1.f + MOD[((size_t)l * 9 + r) * 3072 + 1024 + k]); }
    const int gw = blockIdx.x * 8 + wid, nw = gridDim.x * 8;
    for (int c = gw; c < 2 * (3072 + 1792); c += nw) { int l, col; const bf16_t* W;
        if (c < 2 * 3072) { int e = c / 3072; col = c % 3072; l = 2 * e; W = wb + e * WE_SZ + WE_IN + (size_t)col * 1024; }
        else { int cc = c - 2 * 3072; int o = cc / 1792; col = cc % 1792; l = 2 * o + 1; W = wb + WO_BASE + o * WO_SZ + WO_IN + (size_t)col * 1024; }
        f32x4 w0, w1, w2, w3; { bf16x8 q0 = *(const bf16x8*)(W + lane * 16), q1 = *(const bf16x8*)(W + lane * 16 + 8); f32x4 t0, t1, t2, t3;
            u32x4v u0 = *(u32x4v*)&q0, u1 = *(u32x4v*)&q1;
            w0[0] = __uint_as_float(u0.x << 16); w0[1] = __uint_as_float(u0.x & 0xffff0000u); w0[2] = __uint_as_float(u0.y << 16); w0[3] = __uint_as_float(u0.y & 0xffff0000u);
            w1[0] = __uint_as_float(u0.z << 16); w1[1] = __uint_as_float(u0.z & 0xffff0000u); w1[2] = __uint_as_float(u0.w << 16); w1[3] = __uint_as_float(u0.w & 0xffff0000u);
            w2[0] = __uint_as_float(u1.x << 16); w2[1] = __uint_as_float(u1.x & 0xffff0000u); w2[2] = __uint_as_float(u1.y << 16); w2[3] = __uint_as_float(u1.y & 0xffff0000u);
            w3[0] = __uint_as_float(u1.z << 16); w3[1] = __uint_as_float(u1.z & 0xffff0000u); w3[2] = __uint_as_float(u1.w << 16); w3[3] = __uint_as_float(u1.w & 0xffff0000u); }
#pragma unroll 1
        for (int r = 0; r < 9; ++r) { const float* sh = MOD + ((size_t)l * 9 + r) * 3072 + lane * 16;
            f32x4 s0 = *(const f32x4*)sh, s1 = *(const f32x4*)(sh + 4), s2 = *(const f32x4*)(sh + 8), s3 = *(const f32x4*)(sh + 12); float a = 0.f;
#pragma unroll
            for (int j = 0; j < 4; ++j) a += s0[j] * w0[j] + s1[j] * w1[j] + s2[j] * w2[j] + s3[j] * w3[j];
#pragma unroll
            for (int o = 32; o; o >>= 1) a += __shfl_xor(a, o);
            if (lane == 0) SHW[((size_t)l * 9 + r) * 3072 + col] = a; }
    }
}
__device__ void phase_final(const Params& p) {
    int tid_ = threadIdx.x; asm volatile("" : "+v"(tid_)); const int tid = tid_, wid = tid >> 6, lane = tid & 63; const float* g = p.in[32];
    for (int it = blockIdx.x; it < NB * SEQ / 8; it += gridDim.x) { const size_t r = (size_t)(it * 8 + wid); const bf16_t* x = (const bf16_t*)(p.ws + OFF_X16) + r * 1024; float* o = p.xout + r * 1024;
        f32x4 v[4]; float ss = 0.f;
#pragma unroll
        for (int i = 0; i < 2; ++i) { const u32x4v q = *(const u32x4v*)(x + lane * 8 + 512 * i);
            v[2 * i][0] = __uint_as_float(q.x << 16); v[2 * i][1] = __uint_as_float(q.x & 0xffff0000u); v[2 * i][2] = __uint_as_float(q.y << 16); v[2 * i][3] = __uint_as_float(q.y & 0xffff0000u);
            v[2 * i + 1][0] = __uint_as_float(q.z << 16); v[2 * i + 1][1] = __uint_as_float(q.z & 0xffff0000u); v[2 * i + 1][2] = __uint_as_float(q.w << 16); v[2 * i + 1][3] = __uint_as_float(q.w & 0xffff0000u); }
#pragma unroll
        for (int i = 0; i < 4; ++i) ss += v[i][0] * v[i][0] + v[i][1] * v[i][1] + v[i][2] * v[i][2] + v[i][3] * v[i][3];
#pragma unroll
        for (int o2 = 32; o2; o2 >>= 1) ss += __shfl_xor(ss, o2);
        float rstd = 1.0f / sqrtf(ss * (1.f / 1024.f) + 1e-6f);
#pragma unroll
        for (int i = 0; i < 4; ++i) { int k = lane * 8 + 512 * (i >> 1) + 4 * (i & 1); f32x4 gg = *(const f32x4*)(g + k); f32x4 y;
#pragma unroll
            for (int j = 0; j < 4; ++j) y[j] = v[i][j] * rstd * gg[j];
            *(f32x4*)(o + k) = y; }
    }
}


#define XB_TMO      128
#define XB_XCNT(j)  (256  + 64 * (j))
#define XB_XSUB(j)  (1280 + 64 * (j))
#define XB_XGEN(j)  (2304 + 64 * (j))
#define XB_TOP      3328
#define XB_TOPGEN   3392
#define XCD_BAR_WORDS 3456
#define XB_SPIN_CAP (1u << 22)
#define LAS __attribute__((address_space(3)))
__device__ __forceinline__ unsigned xb_ld(unsigned* p)              { return __hip_atomic_load(p, __ATOMIC_RELAXED, __HIP_MEMORY_SCOPE_AGENT); }
__device__ __forceinline__ unsigned xb_add(unsigned* p, unsigned v) { return __hip_atomic_fetch_add(p, v, __ATOMIC_RELAXED, __HIP_MEMORY_SCOPE_AGENT); }
__device__ __forceinline__ unsigned xb_xcc_id() { return (unsigned)__builtin_amdgcn_s_getreg((3 << 11) | 20) & 0xFu; }
#define XB_SPIN(cond, bar) do { unsigned _sp = 0; while (cond) { __builtin_amdgcn_s_sleep(1); \
    if ((++_sp & 255u) == 0u) { if (xb_ld(&(bar)[XB_TMO])) break; if (_sp > XB_SPIN_CAP) { atomicAdd(&(bar)[XB_TMO], 1u); break; } } } } while (0)
struct XcdBarrier { unsigned* bar; unsigned x; volatile LAS unsigned* st; };
__device__ __forceinline__ XcdBarrier xcd_barrier_post(unsigned* bar, volatile LAS unsigned* st) {
    XcdBarrier b; b.bar = bar; b.x = xb_xcc_id(); b.st = st;
    if (threadIdx.x == 0) (void)xb_add(&bar[XB_XCNT(b.x)], 1u);
    return b;
}
__device__ __forceinline__ void xcd_barrier_complete(unsigned* bar, unsigned x, unsigned& nloc, unsigned& nx) {
    const unsigned G = gridDim.x * gridDim.y * gridDim.z;
    unsigned sum, cnt, mine, sp = 0u;
    for (;;) {
        sum = 0u; cnt = 0u; mine = 0u;
#pragma unroll 1
        for (unsigned j = 0; j < 16; ++j) { const unsigned c = xb_ld(&bar[XB_XCNT(j)]); sum += c; cnt += (c > 0u) ? 1u : 0u; }
        mine = xb_ld(&bar[XB_XCNT(x)]);
        if (sum == G) break;
        __builtin_amdgcn_s_sleep(1);
        if ((++sp & 255u) == 0u) { if (xb_ld(&bar[XB_TMO])) break; if (sp > XB_SPIN_CAP) { atomicAdd(&bar[XB_TMO], 1u); break; } }
    }
    nloc = mine > 0u ? mine : 1u; nx = cnt > 0u ? cnt : 1u;
}
__device__ __forceinline__ void xcd_barrier(const XcdBarrier& b) {
    asm volatile("s_waitcnt vmcnt(0)" ::: "memory");
    __syncthreads();
    if (threadIdx.x == 0) {
        unsigned* bar = b.bar;
        __builtin_amdgcn_s_waitcnt(0);
        unsigned nloc = b.st[0], nx = b.st[1];
        if (nloc == 0u) { xcd_barrier_complete(bar, b.x, nloc, nx); b.st[0] = nloc; b.st[1] = nx; }
        const unsigned old = xb_add(&bar[XB_XSUB(b.x)], 1u);
        const unsigned gen = old / nloc;
        if (old + 1u == (gen + 1u) * nloc) {
            __builtin_amdgcn_fence(__ATOMIC_RELEASE, "agent");
            asm volatile("s_waitcnt vmcnt(0)" ::: "memory");
            const unsigned og = xb_add(&bar[XB_TOP], 1u);
            const unsigned tg = og / nx;
            if (og + 1u == (tg + 1u) * nx) xb_add(&bar[XB_TOPGEN], 1u);
            else XB_SPIN(xb_ld(&bar[XB_TOPGEN]) == tg, bar);
            __builtin_amdgcn_fence(__ATOMIC_ACQUIRE, "agent");
            xb_add(&bar[XB_XGEN(b.x)], 1u);
            asm volatile("s_waitcnt vmcnt(0)" ::: "memory");
        } else {
            XB_SPIN(xb_ld(&bar[XB_XGEN(b.x)]) == gen, bar);
            __builtin_amdgcn_fence(__ATOMIC_ACQUIRE, "agent");
            asm volatile("s_waitcnt vmcnt(0)" ::: "memory");
        }
    }
    __syncthreads();
}

namespace cg = cooperative_groups;
#define GRID_SYNC() do { int nb_ = (PROBE == 12) ? 2 : 1; asm volatile("" : "+s"(nb_)); for (int i_ = 0; i_ < nb_; ++i_) xcd_barrier(xb); } while (0)
#ifndef PROBE
#define PROBE 0
#endif
#ifndef PV
#define PV 1
#endif
__global__ void __launch_bounds__(NTHR) mega(Params p_arg) {
    extern __shared__ __attribute__((aligned(16))) char smem[];
    const Params& p = *(const Params*)__builtin_amdgcn_kernarg_segment_ptr();
    cg::grid_group grid = cg::this_grid();
    char* ws = p.ws; const bf16_t* wb = (const bf16_t*)(ws + OFF_WBF);
    const float2* rtab = (const float2*)(ws + OFF_ROPE);
    volatile LAS unsigned* xst = (volatile LAS unsigned*)(smem + SMEM_BYTES - 16);
    if (threadIdx.x == 0) { xst[0] = 0u; xst[1] = 0u; }
    __syncthreads();
    XcdBarrier xb = xcd_barrier_post((unsigned*)(ws + OFF_BAR), xst);
    if (p.ws == nullptr) grid.sync();
#pragma unroll 1
    for (int l = -1; l < DEPTH; ++l) {
        const int nsub = l < 0 ? 1 : ((l & 1) ? 4 : (l == 0 ? 6 : 5));
#pragma unroll 1
        for (int sub = 0; sub < nsub; ++sub) {
            char* ws = p.ws; asm volatile("" : "+s"(ws));
            const bf16_t* wb = (const bf16_t*)(ws + OFF_WBF); const float2* rtab = (const float2*)(ws + OFF_ROPE);
            const float* SSX = (const float*)(ws + OFF_SSX); bf16_t* ANX = (bf16_t*)(ws + OFF_ACT);
            const float* mod = (const float*)(ws + OFF_MOD) + (size_t)(l < 0 ? 0 : l) * 9 * 3072;
            const float* shw_l = (const float*)(ws + OFF_SHW) + (size_t)(l < 0 ? 0 : l) * 9 * 3072;
            const float* gm_next = (l >= 0 && l + 1 < DEPTH) ? (const float*)(ws + OFF_GM) + (size_t)(l + 1) * 9 * 1024 : nullptr;
            if (l < 0) { phase_prep_weights(p, smem); phase_mod(p, smem); }
            else if ((l & 1) == 0) {
                const int e = l >> 1; const bf16_t* we = wb + e * WE_SZ;
                const int s2 = (l == 0) ? sub : sub + 1;
                if (s2 == 0) { phase_norm0(p, ANX); phase_shw(p); }
                else if (s2 == 1) gemm_phase<4, 4>((const bf16_t*)(ws + E_N), 1024, we + WE_IN, 1024, NTOK, 3072, 1024, VEpiEvenIn{(bf16_t*)p.xout, (bf16_t*)(ws + E_UB), (bf16_t*)(ws + E_MRG), SSX, shw_l}, smem, rtab);
                else if (s2 == 2) { phase_conv(p, e); gemm_phase<3, 8, VEpiS5F, 1>((const bf16_t*)(ws + E_UB), 0, (const bf16_t*)(ws + OFF_TAB + T_MM), 512, 576, 8192, 512, VEpiS5F{(float*)(ws + E_F)}, smem, rtab); }
                else if (s2 == 3) { phase_lru(p, e, smem, 0); phase_s5b(p, smem); }
                else if (s2 == 4) gemm_phase<3, 1>((const bf16_t*)(ws + E_YB), 512, we + WE_GLU, 512, NTOK, 512, 512, VEpiGlu{(const bf16_t*)(ws + E_YB), (bf16_t*)(ws + E_MRG), p.in[24] + e * 512}, smem, rtab);
                else gemm_phase<3, 2>((const bf16_t*)(ws + E_MRG), 1536, we + WE_OUT, 1536, NTOK, 1024, 1536, VEpiResid{p, mod, gm_next, ANX, (float*)(ws + OFF_SSX)}, smem, rtab);
            } else {
                const int o = l >> 1; const bf16_t* wo = wb + WO_BASE + o * WO_SZ; float* SSP = (float*)(ws + O_SSP);
                if (sub == 0) gemm_phase<4, 2>((const bf16_t*)(ws + O_N), 1024, wo + WO_IN, 1024, NTOK, 1792, 1024, VEpiMlaIn{(bf16_t*)(ws + O_CQ), (bf16_t*)(ws + O_CKV), (bf16_t*)(ws + O_KR), (bf16_t*)(ws + O_MSG), SSP, SSX, shw_l}, smem, rtab);
                else if (sub == 1) {
                    gemm_phase<3, 1>((const bf16_t*)(ws + O_CQ), 384, wo + WO_UQ, 384, NTOK, 1536, 384, VEpiRowScale{(bf16_t*)p.xout, QW, SSP, 0, 6, 1.f / 384.f, 192}, smem, rtab);
                    gemm_phase<3, 1>((const bf16_t*)(ws + O_CKV), 256, wo + WO_UKV, 256, NTOK, 2048, 256, VEpiRowScale{(bf16_t*)(ws + O_KV), KVW, SSP, 6, 4, 1.f / 256.f, 0}, smem, rtab);
                }
                else if (sub == 2) phase_attn(p, l < DEPTH - 1, smem);
                else gemm_phase<3, 2>((const bf16_t*)(ws + O_MSG), 1024, wo + WO_OUT, 1024, NTOK, 1024, 1024, VEpiResid{p, mod, gm_next, ANX, (float*)(ws + OFF_SSX)}, smem, rtab);
            }
            { const int tabe = (l == 0 && sub == 0) ? 0 : ((l == 1 && sub == 1) ? 1 : -1);
              if (tabe >= 0) phase_s5_tables(p, tabe, smem); }
            xcd_barrier(xb);
        }
    }
    phase_final(p);
}

extern "C" void kernel_launch(void* const* d_in, const int* in_sizes, int n_in, void* d_out, int out_size, void* d_ws, size_t ws_size, hipStream_t stream) {
    if (n_in != 33 || ws_size < WS_NEED) { fprintf(stderr, "kernel_launch: bad args n_in=%d ws=%zu need=%zu\n", n_in, ws_size, (size_t)WS_NEED); return; }
    Params p{}; for (int i = 0; i < 33; ++i) p.in[i] = (const float*)d_in[i]; p.xout = (float*)d_out; p.ws = (char*)d_ws;
    static int grid_blocks = 0;
    if (!grid_blocks) {
        if (hipFuncSetAttribute((const void*)mega, hipFuncAttributeMaxDynamicSharedMemorySize, SMEM_BYTES) != hipSuccess) { fprintf(stderr, "kernel_launch: hipFuncSetAttribute failed\n"); return; }
        int dev = 0, cus = 0, per_cu = 0;
        (void)hipGetDevice(&dev); (void)hipDeviceGetAttribute(&cus, hipDeviceAttributeMultiprocessorCount, dev);
        (void)hipOccupancyMaxActiveBlocksPerMultiprocessor(&per_cu, mega, NTHR, SMEM_BYTES);
        if (per_cu < 1 || cus < 8) { fprintf(stderr, "kernel_launch: occupancy query gave %d blocks/CU on %d CUs\n", per_cu, cus); return; }
        grid_blocks = (cus / 8) * 8;
    }
    (void)hipMemsetAsync((char*)d_ws + OFF_BAR, 0, XCD_BAR_WORDS * 4, stream);
    void* args[] = {&p};
    hipError_t e = hipLaunchCooperativeKernel((const void*)mega, dim3(grid_blocks), dim3(NTHR), args, SMEM_BYTES, stream);
    if (e != hipSuccess) fprintf(stderr, "kernel_launch: cooperative launch failed: %s (grid %d)\n", hipGetErrorString(e), grid_blocks);
}
```

```cpp
#include <hip/hip_runtime.h>
#include <hip/hip_cooperative_groups.h>
#include <cstdio>
#include <cstdint>
#include <cmath>

typedef unsigned short bf16_t;
typedef short bf16x8 __attribute__((ext_vector_type(8)));
typedef float f32x4 __attribute__((ext_vector_type(4)));
typedef unsigned u32x2 __attribute__((ext_vector_type(2)));

constexpr int D = 1024, NB = 8, SEQ = 2048, CTX = 256, SALL = 2304, NTOK = NB * SALL;
constexpr int DEPTH = 4;
constexpr int EVEN_IN = 3072, EVEN_MIX = 1536, S5W = 512, S5G = 32, S5P = 64, S5H = 16;
constexpr int MLA_IN = 1728, QR = 384, KVR = 256, ROPE = 64, NOPE = 128, VD = 128, HEADS = 8, QW = 1536, KVW = 2048;

constexpr size_t OFF_WBF  = 0;
constexpr size_t SZ_WBF   = 40u << 20;
constexpr size_t OFF_MOD  = OFF_WBF + SZ_WBF;
constexpr size_t SZ_MOD   = 4 * 9 * 3072 * 4;
constexpr size_t OFF_MISC = OFF_MOD + ((SZ_MOD + 255) / 256) * 256;
constexpr size_t SZ_MISC  = 256 << 10;
constexpr size_t OFF_CTXS = OFF_MISC + SZ_MISC;
constexpr size_t SZ_CTXS  = (size_t)NB * CTX * D * 4;
constexpr size_t OFF_TAB  = OFF_CTXS + SZ_CTXS;
constexpr size_t SZ_TAB   = 18u << 20;
constexpr size_t OFF_ACT  = OFF_TAB + SZ_TAB;
constexpr size_t SZ_N   = (size_t)NTOK * D * 2;
constexpr size_t E_N    = OFF_ACT;
constexpr size_t E_UB   = E_N + SZ_N;
constexpr size_t E_MRG  = E_UB + (size_t)NTOK * 512 * 2;
constexpr size_t E_F    = E_MRG + (size_t)NTOK * 1536 * 2;
constexpr size_t E_YB   = E_F + (size_t)NTOK * 512 * 2;
constexpr size_t E_END  = E_YB + (size_t)NTOK * 512 * 2;
constexpr size_t O_KV   = OFF_ACT;
constexpr size_t O_N    = OFF_ACT;
constexpr size_t O_CQ   = O_KV + (size_t)NTOK * KVW * 2;
constexpr size_t O_CKV  = O_CQ + (size_t)NTOK * QR * 2;
constexpr size_t O_KR   = O_CKV + (size_t)NTOK * KVR * 2;
constexpr size_t O_MSG  = O_KR + (size_t)NTOK * ROPE * 2;
constexpr size_t O_SSP  = O_MSG + (size_t)NTOK * D * 2;
constexpr size_t O_END  = O_SSP + (size_t)NTOK * 16 * 4;
constexpr size_t OFF_SSX = O_END > E_END ? O_END : E_END;
constexpr size_t OFF_X16 = OFF_SSX + (size_t)NTOK * 16 * 4;
constexpr size_t WS_NEED = OFF_X16 + (size_t)8 * 2048 * 1024 * 2;

constexpr size_t WE_SZ = 3145728 + 1572864 + 262144 + 524288, WO_SZ = 1835008 + 589824 + 524288 + 1048576;
constexpr size_t WE_IN = 0, WE_OUT = 3145728, WE_GLU = WE_OUT + 1572864, WE_LRU = WE_GLU + 262144;
constexpr size_t WO_BASE = 2 * WE_SZ, WO_IN = 0, WO_UQ = 1835008, WO_UKV = WO_UQ + 589824, WO_OUT = WO_UKV + 524288;
constexpr size_t OFF_SHW = OFF_WBF + (2 * WE_SZ + 2 * WO_SZ) * 2;
constexpr size_t OFF_GM = OFF_SHW + 4 * 9 * 3072 * 4;
static_assert(OFF_GM + 4 * 9 * 1024 * 4 <= SZ_WBF, "weights");
constexpr size_t OFF_ROPE = OFF_MISC;
constexpr size_t OFF_BAR  = OFF_MISC + 16384;

struct Params {
    const float* in[33];
    float* xout;
    char* ws;
};

__device__ __forceinline__ bf16_t f2bf(float f) { unsigned u = __float_as_uint(f); u += 0x7fffu + ((u >> 16) & 1u); return (bf16_t)(u >> 16); }
__device__ __forceinline__ float bf2f(bf16_t h) { return __uint_as_float((unsigned)h << 16); }
__device__ __forceinline__ float silu_f(float x) { return x / (1.f + expf(-x)); }
__device__ __forceinline__ float sigmoid_f(float x) { return 1.f / (1.f + expf(-x)); }
__device__ __forceinline__ float gelu_tanh(float x) { return 0.5f * x * (1.f + tanhf(0.7978845608028654f * (x + 0.044715f * x * x * x))); }
__device__ __forceinline__ int row_cond(int r) { int b = r / SALL; int s = r - b * SALL; return s < CTX ? 8 : b; }
__device__ __forceinline__ bf16_t* resid_row(const Params& p, int r) {
    int b = r / SALL, s = r - b * SALL;
    return s < CTX ? (bf16_t*)(p.ws + OFF_CTXS) + (size_t)(b * CTX + s) * D : (bf16_t*)(p.ws + OFF_X16) + (size_t)(b * SEQ + (s - CTX)) * D;
}

constexpr int NTHR = 512;
constexpr int SMEM_BYTES = 163840;

__device__ __forceinline__ unsigned cvtpk(float lo, float hi);
__device__ __forceinline__ unsigned pack2bf(float a, float b) { return (unsigned)f2bf(a) | ((unsigned)f2bf(b) << 16); }
__device__ __forceinline__ void st_bf4(bf16_t* p, f32x4 v) { u32x2 w; w.x = pack2bf(v[0], v[1]); w.y = pack2bf(v[2], v[3]); *(u32x2*)p = w; }
__device__ __forceinline__ f32x4 ld_bf4(const bf16_t* p) { u32x2 w = *(const u32x2*)p; f32x4 v; v[0] = __uint_as_float(w.x << 16); v[1] = __uint_as_float(w.x & 0xffff0000u); v[2] = __uint_as_float(w.y << 16); v[3] = __uint_as_float(w.y & 0xffff0000u); return v; }

typedef unsigned u32x4v __attribute__((ext_vector_type(4)));
__device__ __forceinline__ void st_bf8(bf16_t* p, f32x4 a, f32x4 b) { u32x4v w; w.x = cvtpk(a[0], a[1]); w.y = cvtpk(a[2], a[3]); w.z = cvtpk(b[0], b[1]); w.w = cvtpk(b[2], b[3]); *(u32x4v*)p = w; }
__device__ __forceinline__ void ld_bf8(const bf16_t* p, f32x4& a, f32x4& b) { u32x4v w = *(const u32x4v*)p;
    a[0] = __uint_as_float(w.x << 16); a[1] = __uint_as_float(w.x & 0xffff0000u); a[2] = __uint_as_float(w.y << 16); a[3] = __uint_as_float(w.y & 0xffff0000u);
    b[0] = __uint_as_float(w.z << 16); b[1] = __uint_as_float(w.z & 0xffff0000u); b[2] = __uint_as_float(w.w << 16); b[3] = __uint_as_float(w.w & 0xffff0000u); }
__device__ __forceinline__ float sigmoid_fast(float x) { return __builtin_amdgcn_rcpf(1.f + __builtin_amdgcn_exp2f(-1.4426950408889634f * x)); }
__device__ __forceinline__ float silu_fast(float x) { return x * sigmoid_fast(x); }

struct WDesc { const float* src; const float* kscale; bf16_t* dst; int K, N, Npad, ldw; float scale; };
__device__ __forceinline__ WDesc get_wdesc(const Params& p, int id) {
    bf16_t* wb = (bf16_t*)(p.ws + OFF_WBF); WDesc d; d.kscale = nullptr; d.scale = 1.f;
    if (id < 70) { int e = id / 35, j = id % 35; bf16_t* base = wb + e * WE_SZ;
        if (j == 0) { d.src = p.in[7] + (size_t)e * 1024 * 3072; d.K = 1024; d.N = 3072; d.Npad = 3072; d.ldw = 3072; d.dst = base + WE_IN; }
        else if (j == 1) { d.src = p.in[25] + (size_t)e * 1536 * 1024; d.K = 1536; d.N = 1024; d.Npad = 1024; d.ldw = 1024; d.dst = base + WE_OUT; }
        else if (j == 2) { d.src = p.in[23] + (size_t)e * 512 * 512; d.K = 512; d.N = 512; d.Npad = 512; d.ldw = 512; d.dst = base + WE_GLU; }
        else { int q = j - 3; int h = q & 7, gate = (q >> 3) & 1, dd = q >> 4;
            d.src = p.in[gate ? 12 : 10] + ((size_t)((e * 2 + dd) * 8 + h)) * 16384; d.K = 128; d.N = 128; d.Npad = 128; d.ldw = 128; d.scale = -1.4426950408889634f;
            d.dst = base + WE_LRU + (size_t)h * 512 * 128 + (size_t)((dd * 2 + gate) * 128) * 128; }
    } else { int o = (id - 70) / 4, j = (id - 70) % 4; bf16_t* base = wb + WO_BASE + o * WO_SZ;
        if (j == 0) { d.src = p.in[26] + (size_t)o * 1024 * 1728; d.K = 1024; d.N = 1728; d.Npad = 1792; d.ldw = 1728; d.dst = base + WO_IN; }
        else if (j == 1) { d.src = p.in[28] + (size_t)o * 384 * 1536; d.K = 384; d.N = 1536; d.Npad = 1536; d.ldw = 1536; d.dst = base + WO_UQ; d.kscale = p.in[27] + o * 384; }
        else if (j == 2) { d.src = p.in[30] + (size_t)o * 256 * 2048; d.K = 256; d.N = 2048; d.Npad = 2048; d.ldw = 2048; d.dst = base + WO_UKV; d.kscale = p.in[29] + o * 256; }
        else { d.src = p.in[31] + (size_t)o * 1024 * 1024; d.K = 1024; d.N = 1024; d.Npad = 1024; d.ldw = 1024; d.dst = base + WO_OUT; }
    }
    return d;
}
constexpr int N_WDESC = 78;
__device__ void phase_prep_weights(const Params& p, char* smem) {
    float* tile = (float*)smem;
    int tid_ = threadIdx.x; asm volatile("" : "+v"(tid_)); const int tid = tid_;
    const int kk0 = tid >> 4, c4 = (tid & 15) * 4;
    int id = 0, base = 0; WDesc d = get_wdesc(p, 0); int tk = d.K / 64, nt = tk * (d.Npad / 64);
    int t = blockIdx.x;
    auto seek = [&](int tt) { while (id < N_WDESC && tt >= base + nt) { base += nt; ++id; if (id < N_WDESC) { d = get_wdesc(p, id); tk = d.K / 64; nt = tk * (d.Npad / 64); } } };
    auto ldtile = [&](const WDesc& dd, int k0, int n0, f32x4& v0, f32x4& v1) {
        const int n = n0 + c4; const bool in = n < dd.N;
        v0 = in ? *(const f32x4*)(dd.src + (size_t)(k0 + kk0) * dd.ldw + n) : (f32x4){0.f, 0.f, 0.f, 0.f};
        v1 = in ? *(const f32x4*)(dd.src + (size_t)(k0 + kk0 + 32) * dd.ldw + n) : (f32x4){0.f, 0.f, 0.f, 0.f}; };
    seek(t);
    f32x4 a0, a1; WDesc dc = d; int k0c = 0, n0c = 0; bool have = id < N_WDESC;
    if (have) { int lt = t - base; k0c = (lt % tk) * 64; n0c = (lt / tk) * 64; ldtile(dc, k0c, n0c, a0, a1); }
    while (have) {
        const int tn = t + gridDim.x; seek(tn);
        f32x4 b0 = {0.f, 0.f, 0.f, 0.f}, b1 = {0.f, 0.f, 0.f, 0.f}; WDesc dn = d; int k0n = 0, n0n = 0; const bool haven = id < N_WDESC;
        if (haven) { int lt = tn - base; k0n = (lt % tk) * 64; n0n = (lt / tk) * 64; ldtile(dn, k0n, n0n, b0, b1); }
        const float s0 = (dc.kscale ? dc.kscale[k0c + kk0] * dc.scale : dc.scale), s1 = (dc.kscale ? dc.kscale[k0c + kk0 + 32] * dc.scale : dc.scale);
        __syncthreads();
#pragma unroll
        for (int j = 0; j < 4; ++j) { tile[kk0 * 65 + c4 + j] = a0[j] * s0; tile[(kk0 + 32) * 65 + c4 + j] = a1[j] * s1; }
        __syncthreads();
        { int n = tid >> 3, k8 = (tid & 7) * 8; unsigned w[4];
#pragma unroll
          for (int j = 0; j < 4; ++j) w[j] = cvtpk(tile[(k8 + 2 * j) * 65 + n], tile[(k8 + 2 * j + 1) * 65 + n]);
          uint4 o; o.x = w[0]; o.y = w[1]; o.z = w[2]; o.w = w[3];
          *(uint4*)(dc.dst + (size_t)(n0c + n) * dc.K + k0c + k8) = o; }
        t = tn; have = haven; dc = dn; k0c = k0n; n0c = n0n; a0 = b0; a1 = b1;
    }
    if (blockIdx.x == 0) { float2* tab = (float2*)(p.ws + OFF_ROPE);
        for (int i = tid; i < 1024; i += NTHR) { int pos = i >> 4, f = i & 15; float inv = powf(10000.f, -(float)(2 * f) / 32.f); float ang = (float)pos * inv; tab[i] = make_float2(cosf(ang), sinf(ang)); } }
}

template <int MF> __device__ __forceinline__ void rope_rotate(f32x4 (&acc)[MF][4], int row0, int fr, int fq, const float2* tab) {
#pragma unroll
    for (int m = 0; m < MF; ++m) { int r = row0 + m * 16 + fr; int s = r % SALL; int t = s - CTX; if (t < 0) t = 0;
        const int pos = fq < 2 ? (t >> 6) : (t & 63);
#pragma unroll
        for (int tt = 0; tt < 2; ++tt) {
#pragma unroll
            for (int j = 0; j < 4; ++j) { float2 cs = tab[pos * 16 + ((8 * fq + 4 * tt + j) & 15)]; float a = acc[m][tt][j], b = acc[m][tt + 2][j];
                if (s >= CTX) { acc[m][tt][j] = a * cs.x - b * cs.y; acc[m][tt + 2][j] = b * cs.x + a * cs.y; } } } }
}
template <int MF, int NG, class Epi, int AMODE = 0>
__device__ void gemm_phase(const bf16_t* __restrict__ A, int lda, const bf16_t* __restrict__ Bt, int ldb, int M, int N, int K, const Epi& epi, char* smem, const float2* rope_tab) {
    constexpr int BM = 64 * MF, A_BYTES = BM * 128, B_BYTES = 128 * 128, STAGE = A_BYTES + B_BYTES;
    static_assert(3 * STAGE <= SMEM_BYTES - 16, "gemm lds");
    int tid_ = threadIdx.x; asm volatile("" : "+v"(tid_)); const int tid = tid_, wid = tid >> 6, lane = tid & 63, wm = wid >> 1, wn = wid & 1, fr = lane & 15, fq = lane >> 4;
    const int nM = M / BM, nN = N / 128, nk = K / 64;
    const int widu = __builtin_amdgcn_readfirstlane(wid);
    const int xcd = blockIdx.x & 7, jw = blockIdx.x >> 3, nj = gridDim.x >> 3;
    constexpr int MGC = 8 / NG; const int ng = xcd % NG, mg = xcd / NG, gn = nN / NG;
    const int npx = (nM - mg + MGC - 1) / MGC;
    const int ldr = tid >> 3, ldc = ((tid & 7) ^ (ldr & 7)) << 3;
    const int ldrB = (ldr & ~31) | (8 * ((ldr & 15) >> 2) + 4 * ((ldr & 31) >> 4) + (ldr & 3));
    const unsigned voA = (unsigned)(ldr * lda + ldc) * 2u, voB = (unsigned)(ldrB * ldb + ldc) * 2u;
#define GEMM_AROW(pmx, pnx, i_) (AMODE == 0 ? A + (size_t)((pmx) * BM + (i_) * 64 + ldr) * lda + ldc \
        : A + ((size_t)(((pmx) * BM + (i_) * 64 + ldr) / 72) * SALL + (((pmx) * BM + (i_) * 64 + ldr) % 72) * 32 + (ldc >> 4)) * 512 + ((pnx) >> 1) * 16 + (ldc & 15))
#define GEMM_DMA(sbase, voff, dst) asm volatile("s_mov_b32 m0, %2\n\ts_nop 0\n\tglobal_load_lds_dwordx4 %0, %1" :: "v"(voff), "s"(sbase), "s"((unsigned)(uintptr_t)(dst)) : "memory", "m0")
#define GEMM_STAGE_A(buf, k0) do { char* As_ = smem + (buf) * STAGE; \
        if constexpr (AMODE == 0) { _Pragma("unroll") for (int i_ = 0; i_ < MF; ++i_) GEMM_DMA(Aub + ((size_t)(i_ * 64) * lda + (k0)) * 2, voA, As_ + widu * 1024 + i_ * 8192); } \
        else { _Pragma("unroll") for (int i_ = 0; i_ < MF; ++i_) __builtin_amdgcn_global_load_lds((const unsigned*)(Ag[i_] + (k0) * 32), (__attribute__((address_space(3))) unsigned*)(As_ + widu * 1024 + i_ * 8192), 16, 0, 0); } } while (0)
#define GEMM_STAGE_B(buf, k0) do { char* Bs_ = smem + (buf) * STAGE + A_BYTES; \
        if constexpr (AMODE == 0) { _Pragma("unroll") for (int i_ = 0; i_ < 2; ++i_) GEMM_DMA(Bub + ((size_t)(i_ * 64) * ldb + (k0)) * 2, voB, Bs_ + widu * 1024 + i_ * 8192); } \
        else { _Pragma("unroll") for (int i_ = 0; i_ < 2; ++i_) __builtin_amdgcn_global_load_lds((const unsigned*)(Bg + (size_t)(i_ * 64) * ldb + (k0)), (__attribute__((address_space(3))) unsigned*)(Bs_ + widu * 1024 + i_ * 8192), 16, 0, 0); } } while (0)
#define GEMM_STAGE(buf, k0) do { GEMM_STAGE_A(buf, k0); GEMM_STAGE_B(buf, k0); } while (0)
#define GEMM_LOADF(AF, WF, bufi, ks) do { const char* As_ = smem + (bufi) * STAGE; const char* Bs_ = As_ + A_BYTES; \
        _Pragma("unroll") for (int n_ = 0; n_ < 4; ++n_) { int row_ = wn * 64 + n_ * 16 + fr; WF[n_] = *(const bf16x8*)(Bs_ + row_ * 128 + ((((ks) * 4 + fq) ^ (row_ & 7)) << 4)); } \
        _Pragma("unroll") for (int m_ = 0; m_ < MF; ++m_) { int row_ = wm * (16 * MF) + m_ * 16 + fr; AF[m_] = *(const bf16x8*)(As_ + row_ * 128 + ((((ks) * 4 + fq) ^ (row_ & 7)) << 4)); } } while (0)
#define SBAR() __builtin_amdgcn_sched_barrier(0)
#define GEMM_MMA1(m_, n_, AF, WF) acc[m_][n_] = __builtin_amdgcn_mfma_f32_16x16x32_bf16(WF[n_], AF[m_], acc[m_][n_], 0, 0, 0)
#define GEMM_LDW1(WF, n_, bufi, ks) do { const char* Bs_ = smem + (bufi) * STAGE + A_BYTES; int row_ = wn * 64 + (n_) * 16 + fr; WF[n_] = *(const bf16x8*)(Bs_ + row_ * 128 + ((((ks) * 4 + fq) ^ (row_ & 7)) << 4)); } while (0)
#define GEMM_LDA1(AF, m_, bufi, ks) do { const char* As_ = smem + (bufi) * STAGE; int row_ = wm * (16 * MF) + (m_) * 16 + fr; AF[m_] = *(const bf16x8*)(As_ + row_ * 128 + ((((ks) * 4 + fq) ^ (row_ & 7)) << 4)); } while (0)
#define GEMM_LOADW(WF, bufi, ks) do { const char* Bs_ = smem + (bufi) * STAGE + A_BYTES; \
        _Pragma("unroll") for (int n_ = 0; n_ < 4; ++n_) { int row_ = wn * 64 + n_ * 16 + fr; WF[n_] = *(const bf16x8*)(Bs_ + row_ * 128 + ((((ks) * 4 + fq) ^ (row_ & 7)) << 4)); } } while (0)
#define GEMM_LOADA(AF, bufi, ks) do { const char* As_ = smem + (bufi) * STAGE; \
        _Pragma("unroll") for (int m_ = 0; m_ < MF; ++m_) { int row_ = wm * (16 * MF) + m_ * 16 + fr; AF[m_] = *(const bf16x8*)(As_ + row_ * 128 + ((((ks) * 4 + fq) ^ (row_ & 7)) << 4)); } } while (0)
#define GEMM_MMA_ROW(m_, AF, WF) do { _Pragma("unroll") for (int n_ = 0; n_ < 4; ++n_) acc[m_][n_] = __builtin_amdgcn_mfma_f32_16x16x32_bf16(WF[n_], AF[m_], acc[m_][n_], 0, 0, 0); } while (0)
#define GEMM_MMA(AF, WF) do { __builtin_amdgcn_s_setprio(1); \
        _Pragma("unroll") for (int m_ = 0; m_ < MF; ++m_) _Pragma("unroll") for (int n_ = 0; n_ < 4; ++n_) acc[m_][n_] = __builtin_amdgcn_mfma_f32_16x16x32_bf16(WF[n_], AF[m_], acc[m_][n_], 0, 0, 0); \
        __builtin_amdgcn_s_setprio(0); } while (0)
#define GEMM_TILE(itx, PM, PN) do { PM = mg + MGC * ((itx) / gn); PN = ng * gn + (itx) % gn; } while (0)
    const int nitems = npx * gn;
    if (__builtin_amdgcn_readfirstlane(wid) >= 4) __builtin_amdgcn_s_setprio(1);
    int it = jw;
    if (it < nitems) {
        int pm, pn; GEMM_TILE(it, pm, pn);
        const bf16_t* Ag[MF];
#pragma unroll
        for (int i = 0; i < MF; ++i) Ag[i] = GEMM_AROW(pm, pn, i);
        const bf16_t* Bg = Bt + (size_t)(pn * 128 + ldrB) * ldb + ldc;
        const char* Aub = (const char*)(A + (size_t)(pm * BM) * lda); const char* Bub = (const char*)(Bt + (size_t)(pn * 128) * ldb);
        __syncthreads();
        GEMM_STAGE(0, 0); if (nk > 1) GEMM_STAGE(1, 64);
    }
    for (; it < nitems; it += nj) {
        int pm, pn; GEMM_TILE(it, pm, pn);
        const int brow = pm * BM, bcol = pn * 128;
        f32x4 acc[MF][4];
#pragma unroll
        for (int m = 0; m < MF; ++m)
#pragma unroll
            for (int n = 0; n < 4; ++n) acc[m][n] = (f32x4){0.f, 0.f, 0.f, 0.f};
        const bf16_t* Ag[MF];
#pragma unroll
        for (int i = 0; i < MF; ++i) Ag[i] = GEMM_AROW(pm, pn, i);
        const bf16_t* Bg = Bt + (size_t)(bcol + ldrB) * ldb + ldc;
        const char* Aub = (const char*)(A + (size_t)brow * lda); const char* Bub = (const char*)(Bt + (size_t)bcol * ldb);
        asm volatile("s_waitcnt vmcnt(0)" ::: "memory");
        asm volatile("" ::: "memory"); __builtin_amdgcn_s_barrier(); asm volatile("" ::: "memory");
        bf16x8 a0[MF], w0[4], a1[MF], w1[4];
        GEMM_LOADF(a0, w0, 0, 0);
        __builtin_amdgcn_s_waitcnt(0xC07F);
        int buf = 0;
        for (int kt = 0; kt < nk; ++kt) {
            const bool more = kt + 2 < nk; int nb2 = buf + 2; if (nb2 >= 3) nb2 -= 3;
            SBAR();
#pragma unroll
            for (int n_ = 0; n_ < 4; ++n_) { GEMM_MMA1(0, n_, a0, w0); SBAR(); GEMM_LDW1(w1, n_, buf, 1); SBAR(); }
            if (MF > 1) {
#pragma unroll
                for (int n_ = 0; n_ < 4; ++n_) { GEMM_MMA1(1, n_, a0, w0); SBAR(); if (n_ < MF) { GEMM_LDA1(a1, n_, buf, 1); SBAR(); } } }
            else { GEMM_LOADA(a1, buf, 1); SBAR(); }
            if (more) GEMM_STAGE_A(nb2, (kt + 2) * 64);
            SBAR();
            if (MF > 2) { GEMM_MMA_ROW(2, a0, w0); SBAR(); }
            if (more) GEMM_STAGE_B(nb2, (kt + 2) * 64);
            SBAR();
            if (MF > 3) { GEMM_MMA_ROW(3, a0, w0); SBAR(); }
            if (kt + 1 < nk) {
                if (more) { if (MF == 4) asm volatile("s_waitcnt vmcnt(6)" ::: "memory"); else if (MF == 3) asm volatile("s_waitcnt vmcnt(5)" ::: "memory"); else asm volatile("s_waitcnt vmcnt(4)" ::: "memory"); }
                else asm volatile("s_waitcnt vmcnt(0)" ::: "memory");
            }
            __builtin_amdgcn_s_waitcnt(0xC07F);
            asm volatile("" ::: "memory"); __builtin_amdgcn_s_barrier(); asm volatile("" ::: "memory");
            int nb = buf + 1; if (nb >= 3) nb -= 3;
            const bool nxt = kt + 1 < nk;
            SBAR();
#pragma unroll
            for (int n_ = 0; n_ < 4; ++n_) { GEMM_MMA1(0, n_, a1, w1); SBAR(); if (nxt) { GEMM_LDW1(w0, n_, nb, 0); SBAR(); } }
            if (MF > 1) {
#pragma unroll
                for (int n_ = 0; n_ < 4; ++n_) { GEMM_MMA1(1, n_, a1, w1); SBAR(); if (nxt && n_ < MF) { GEMM_LDA1(a0, n_, nb, 0); SBAR(); } } }
            else { if (nxt) GEMM_LOADA(a0, nb, 0); SBAR(); }
            if (MF > 2) { GEMM_MMA_ROW(2, a1, w1); SBAR(); }
            if (MF > 3) { GEMM_MMA_ROW(3, a1, w1); SBAR(); }
            __builtin_amdgcn_s_waitcnt(0xC07F);
            buf = nb;
        }
        float rstd_m[MF]; f32x4 shw_n[4];
        if constexpr (Epi::HAS_PRE) {
            float* rs = (float*)(smem + 2 * STAGE);
            if (tid < 2 * BM) { const int rr = tid >> 1; const f32x4* s = (const f32x4*)(epi.SSX + (size_t)(brow + rr) * 16 + (tid & 1) * 8); const f32x4 a = s[0], b = s[1];
                float t = (a[0] + a[1]) + (a[2] + a[3]) + (b[0] + b[1]) + (b[2] + b[3]); t += __shfl_xor(t, 1);
                if ((tid & 1) == 0) rs[rr] = 1.0f / sqrtf(t * (1.f / 1024.f) + 1e-6f); }
            __syncthreads();
#pragma unroll
            for (int m = 0; m < MF; ++m) rstd_m[m] = rs[wm * (16 * MF) + m * 16 + fr];
            const float* shw = epi.shw_l + row_cond(brow) * 3072 + (bcol + wn * 64) + 8 * fq;
#pragma unroll
            for (int n = 0; n < 4; ++n) shw_n[n] = *(const f32x4*)(shw + 32 * (n >> 1) + 4 * (n & 1));
            __builtin_amdgcn_s_waitcnt(0xC07F);
            asm volatile("s_waitcnt vmcnt(0)" ::: "memory");
        }
        if (it + nj < nitems) { int pm2, pn2; GEMM_TILE(it + nj, pm2, pn2);
            const bf16_t* Bg2 = Bt + (size_t)(pn2 * 128 + ldrB) * ldb + ldc;
            { const bf16_t* Ag[MF];
#pragma unroll
              for (int i = 0; i < MF; ++i) Ag[i] = GEMM_AROW(pm2, pn2, i);
              const bf16_t* Bg = Bg2; const char* Aub = (const char*)(A + (size_t)(pm2 * BM) * lda); const char* Bub = (const char*)(Bt + (size_t)(pn2 * 128) * ldb);
              GEMM_STAGE(0, 0); if (nk > 1) GEMM_STAGE(1, 64); } }
        const int row0 = brow + wm * (16 * MF), col0 = bcol + wn * 64;
        if constexpr (Epi::HAS_PRE) {
#pragma unroll
            for (int m = 0; m < MF; ++m)
#pragma unroll
                for (int n = 0; n < 4; ++n)
#pragma unroll
                    for (int j = 0; j < 4; ++j) acc[m][n][j] = acc[m][n][j] * rstd_m[m] + shw_n[n][j]; }
        if (Epi::HAS_ROWSS) { if (epi.rowss_block(col0)) {
#pragma unroll
            for (int m = 0; m < MF; ++m) { float s = 0.f;
#pragma unroll
                for (int n = 0; n < 4; ++n)
#pragma unroll
                    for (int j = 0; j < 4; ++j) s += acc[m][n][j] * acc[m][n][j];
                s += __shfl_xor(s, 16); s += __shfl_xor(s, 32);
                if (fq == 0) epi.rowss(row0 + m * 16 + fr, col0, s); } } }
        if (Epi::HAS_ROPE) { if (epi.rope_block(col0)) rope_rotate<MF>(acc, row0, fr, fq, rope_tab); }
        if constexpr (Epi::HAS_PRELOAD) {
            typename Epi::PL pl[MF][2];
#pragma unroll
            for (int m = 0; m < MF; ++m) { const int row = row0 + m * 16 + fr; const auto rc = epi.row_ctx(row);
#pragma unroll
                for (int g = 0; g < 2; ++g) pl[m][g] = epi.preload(rc, row, col0 + 32 * g + 8 * fq); }
#pragma unroll
            for (int m = 0; m < MF; ++m) { const int row = row0 + m * 16 + fr; const auto rc = epi.row_ctx(row); float ssq = 0.f;
#pragma unroll
                for (int g = 0; g < 2; ++g) ssq += epi.vec8p(rc, row, col0 + 32 * g + 8 * fq, acc[m][2 * g], acc[m][2 * g + 1], pl[m][g]);
                if (Epi::HAS_ROWSS_POST) { ssq += __shfl_xor(ssq, 16); ssq += __shfl_xor(ssq, 32); if (fq == 0) epi.rowss_post(row, col0, ssq); } }
        } else {
#pragma unroll
        for (int m = 0; m < MF; ++m) { const int row = row0 + m * 16 + fr; const auto rc = epi.row_ctx(row);
#pragma unroll
            for (int g = 0; g < 2; ++g) epi.vec8(rc, row, col0 + 32 * g + 8 * fq, acc[m][2 * g], acc[m][2 * g + 1]); }
        }
    }
    __builtin_amdgcn_s_setprio(0);
#undef GEMM_AROW
#undef GEMM_STAGE
#undef GEMM_MMA1
#undef GEMM_LDW1
#undef GEMM_LDA1
#undef GEMM_DMA
#undef GEMM_LOADF
#undef GEMM_MMA
#undef GEMM_STAGE_A
#undef GEMM_STAGE_B
#undef GEMM_LOADW
#undef GEMM_LOADA
#undef GEMM_MMA_ROW
#undef GEMM_TILE
}

struct NoCtx {};
struct PreCtx { float rstd; const float* shw; };
__device__ __forceinline__ PreCtx pre_ctx(const float* SSX, const float* shw_l, int r) { const f32x4* s = (const f32x4*)(SSX + (size_t)r * 16); f32x4 a = s[0], b = s[1], c = s[2], d = s[3];
    float t = (a[0] + a[1]) + (a[2] + a[3]) + (b[0] + b[1]) + (b[2] + b[3]) + (c[0] + c[1]) + (c[2] + c[3]) + (d[0] + d[1]) + (d[2] + d[3]);
    return PreCtx{1.0f / sqrtf(t * (1.f / 1024.f) + 1e-6f), shw_l + row_cond(r) * 3072}; }
struct VEpiEvenIn { static constexpr bool HAS_PRE = true; static constexpr bool HAS_PRELOAD = false; struct PL {}; static constexpr bool HAS_ROPE = false, HAS_ROWSS = false; bf16_t* XA; bf16_t* UB; bf16_t* MRG; const float* SSX; const float* shw_l;
    __device__ __forceinline__ bool rope_block(int) const { return false; }
    __device__ __forceinline__ bool rowss_block(int) const { return false; }
    __device__ __forceinline__ void rowss(int, int, float) const {}
    __device__ __forceinline__ NoCtx row_ctx(int) const { return NoCtx{}; }
    __device__ __forceinline__ void vec8(const NoCtx&, int r, int c, f32x4 lo, f32x4 hi) const {
        if (c < 1024) st_bf8(XA + (size_t)r * 1024 + c, lo, hi);
        else if (c < 2048) { for (int j = 0; j < 4; ++j) { lo[j] = silu_fast(lo[j]); hi[j] = silu_fast(hi[j]); } st_bf8(MRG + (size_t)r * 1536 + (c - 1024), lo, hi); }
        else if (c < 2560) st_bf8(UB + (size_t)r * 512 + (c - 2048), lo, hi);
        else { for (int j = 0; j < 4; ++j) { lo[j] = silu_fast(lo[j]); hi[j] = silu_fast(hi[j]); } st_bf8(MRG + (size_t)r * 1536 + 1024 + (c - 2560), lo, hi); }
    } };
struct VEpiGlu { static constexpr bool HAS_ROWSS_POST = false; __device__ __forceinline__ void rowss_post(int, int, float) const {} static constexpr bool HAS_PRE = false; static constexpr bool HAS_PRELOAD = true; struct PL { f32x4 y0, y1, g0, g1; }; static constexpr bool HAS_ROPE = false, HAS_ROWSS = false; const bf16_t* YB; bf16_t* MRG; const float* bias;
    __device__ __forceinline__ bool rope_block(int) const { return false; }
    __device__ __forceinline__ bool rowss_block(int) const { return false; }
    __device__ __forceinline__ void rowss(int, int, float) const {}
    __device__ __forceinline__ NoCtx row_ctx(int) const { return NoCtx{}; }
    __device__ __forceinline__ PL preload(const NoCtx&, int r, int c) const { PL q; ld_bf8(YB + (size_t)r * 512 + c, q.y0, q.y1); ld_bf8(MRG + (size_t)r * 1536 + 1024 + c, q.g0, q.g1); return q; }
    __device__ __forceinline__ float vec8p(const NoCtx&, int r, int c, f32x4 lo, f32x4 hi, const PL& q) const {
        f32x4 b0 = *(const f32x4*)(bias + c), b1 = *(const f32x4*)(bias + c + 4);
        for (int j = 0; j < 4; ++j) { lo[j] = q.y0[j] * sigmoid_fast(lo[j] + b0[j]) * q.g0[j]; hi[j] = q.y1[j] * sigmoid_fast(hi[j] + b1[j]) * q.g1[j]; }
        st_bf8(MRG + (size_t)r * 1536 + 1024 + c, lo, hi); return 0.f;
    } };
struct VEpiS5F { static constexpr bool HAS_PRE = false; static constexpr bool HAS_PRELOAD = false; struct PL {}; static constexpr bool HAS_ROPE = false, HAS_ROWSS = false; float* F;
    __device__ __forceinline__ bool rope_block(int) const { return false; }
    __device__ __forceinline__ bool rowss_block(int) const { return false; }
    __device__ __forceinline__ void rowss(int, int, float) const {}
    __device__ __forceinline__ NoCtx row_ctx(int) const { return NoCtx{}; }
    __device__ __forceinline__ void vec8(const NoCtx&, int r, int c, f32x4 lo, f32x4 hi) const { float* f = F + ((size_t)r * 32 + (c >> 8)) * 256 + (c & 255); *(f32x4*)f = lo; *(f32x4*)(f + 4) = hi; } };
struct ResidCtx { bf16_t* x; const float* g; const float* gm; };
struct VEpiResid { static constexpr bool HAS_ROWSS_POST = true; static constexpr bool HAS_PRE = false; static constexpr bool HAS_PRELOAD = true; struct PL { u32x4v xv; }; static constexpr bool HAS_ROPE = false, HAS_ROWSS = false;
    Params p; const float* mod; const float* gm_next; bf16_t* An; float* SSX;
    __device__ __forceinline__ bool rope_block(int) const { return false; }
    __device__ __forceinline__ bool rowss_block(int) const { return false; }
    __device__ __forceinline__ void rowss(int, int, float) const {}
    __device__ __forceinline__ void rowss_post(int r, int c0, float s) const { if (gm_next) SSX[(size_t)r * 16 + (c0 >> 6)] = s; }
    __device__ __forceinline__ ResidCtx row_ctx(int r) const { const int cd = row_cond(r); return ResidCtx{resid_row(p, r), mod + cd * 3072 + 2048, gm_next ? gm_next + cd * 1024 : nullptr}; }
    __device__ __forceinline__ PL preload(const ResidCtx& rc, int r, int c) const { PL q; q.xv = *(const u32x4v*)(rc.x + c); return q; }
    __device__ __forceinline__ float vec8p(const ResidCtx& rc, int r, int c, f32x4 lo, f32x4 hi, const PL& q) const {
        bf16_t* x = rc.x + c; f32x4 x0, x1; x0[0] = __uint_as_float(q.xv.x << 16); x0[1] = __uint_as_float(q.xv.x & 0xffff0000u); x0[2] = __uint_as_float(q.xv.y << 16); x0[3] = __uint_as_float(q.xv.y & 0xffff0000u);
        x1[0] = __uint_as_float(q.xv.z << 16); x1[1] = __uint_as_float(q.xv.z & 0xffff0000u); x1[2] = __uint_as_float(q.xv.w << 16); x1[3] = __uint_as_float(q.xv.w & 0xffff0000u); f32x4 g0 = *(const f32x4*)(rc.g + c), g1 = *(const f32x4*)(rc.g + c + 4);
        for (int j = 0; j < 4; ++j) { x0[j] += g0[j] * lo[j]; x1[j] += g1[j] * hi[j]; }
        st_bf8(x, x0, x1);
        float ss = 0.f;
        if (rc.gm) { f32x4 m0 = *(const f32x4*)(rc.gm + c), m1 = *(const f32x4*)(rc.gm + c + 4); f32x4 a0, a1;
            for (int j = 0; j < 4; ++j) { ss += x0[j] * x0[j] + x1[j] * x1[j]; a0[j] = x0[j] * m0[j]; a1[j] = x1[j] * m1[j]; }
            st_bf8(An + (size_t)r * 1024 + c, a0, a1); }
        return ss;
    } };
struct VEpiMlaIn { static constexpr bool HAS_PRE = true; static constexpr bool HAS_PRELOAD = false; struct PL {}; static constexpr bool HAS_ROPE = true, HAS_ROWSS = true; bf16_t* CQ; bf16_t* CKV; bf16_t* KR; bf16_t* MSG; float* SSP; const float* SSX; const float* shw_l;
    __device__ __forceinline__ bool rope_block(int c0) const { return c0 == 640; }
    __device__ __forceinline__ bool rowss_block(int c0) const { return c0 < 640; }
    __device__ __forceinline__ void rowss(int r, int c0, float s) const { SSP[(size_t)r * 16 + (c0 >> 6)] = s; }
    __device__ __forceinline__ NoCtx row_ctx(int) const { return NoCtx{}; }
    __device__ __forceinline__ void vec8(const NoCtx&, int r, int c, f32x4 lo, f32x4 hi) const {
        if (c < 384) st_bf8(CQ + (size_t)r * 384 + c, lo, hi);
        else if (c < 640) st_bf8(CKV + (size_t)r * 256 + (c - 384), lo, hi);
        else if (c < 704) st_bf8(KR + (size_t)r * 64 + (c - 640), lo, hi);
        else if (c < 1728) { for (int j = 0; j < 4; ++j) { lo[j] = silu_fast(lo[j]); hi[j] = silu_fast(hi[j]); } st_bf8(MSG + (size_t)r * 1024 + (c - 704), lo, hi); }
    } };
struct VEpiRowScale { static constexpr bool HAS_PRE = false; static constexpr bool HAS_PRELOAD = false; struct PL {}; static constexpr bool HAS_ROPE = true, HAS_ROWSS = false; bf16_t* O; int ldo; const float* SSP; int t0, nt; float invk; int rope_mod;
    __device__ __forceinline__ bool rope_block(int c0) const { return rope_mod != 0 && (c0 % 192) == 128; }
    __device__ __forceinline__ bool rowss_block(int) const { return false; }
    __device__ __forceinline__ void rowss(int, int, float) const {}
    __device__ __forceinline__ float row_ctx(int r) const { float s = 0.f; for (int t = 0; t < nt; ++t) s += SSP[(size_t)r * 16 + t0 + t]; return 1.0f / sqrtf(s * invk + 1e-6f); }
    __device__ __forceinline__ void vec8(const float& rstd, int r, int c, f32x4 lo, f32x4 hi) const { for (int j = 0; j < 4; ++j) { lo[j] *= rstd; hi[j] *= rstd; } st_bf8(O + (size_t)r * ldo + c, lo, hi); } };

typedef short s16x4 __attribute__((ext_vector_type(4)));
typedef float f32x16 __attribute__((ext_vector_type(16)));
typedef unsigned u32x4 __attribute__((ext_vector_type(4)));
constexpr float ATT_SCALE = 0.07216878364870322f;
constexpr float ATT_THR = 8.f;
constexpr int SHM_V = 64 * 128 * 2, SHM_K = 64 * 128 * 2, SHM_R = 64 * 64 * 2;
#define KSWZ(row, colB) ((row) * 256 + ((colB) ^ (((row) & 15) << 4)))
#define RSWZF(row) ((((row) >> 1) & 3) | ((((row) >> 4) & 1) << 2))
#define RSWZ(row, colB) ((row) * 128 + ((colB) ^ (RSWZF(row) << 4)))
__device__ __forceinline__ int crow(int r, int hi) { return (r & 3) + 8 * (r >> 2) + 4 * hi; }
__device__ __forceinline__ unsigned cvtpk(float lo, float hi) { unsigned r; asm volatile("v_cvt_pk_bf16_f32 %0, %1, %2" : "=v"(r) : "v"(lo), "v"(hi)); return r; }
__device__ __forceinline__ void partialSM(f32x16& p0, f32x16& p1, float& m_reg, float& mn, float& alpha) {
    constexpr float C = ATT_SCALE * 1.4426950408889634f;
    float pmax = p0[0];
#pragma unroll
    for (int r = 1; r < 16; ++r) pmax = fmaxf(pmax, p0[r]);
#pragma unroll
    for (int r = 0; r < 16; ++r) pmax = fmaxf(pmax, p1[r]);
    { auto rr = __builtin_amdgcn_permlane32_swap(__float_as_uint(pmax), __float_as_uint(pmax), false, false);
      pmax = fmaxf(__uint_as_float(rr[0]), __uint_as_float(rr[1])); }
    if (__builtin_expect(__all(pmax - m_reg <= ATT_THR / ATT_SCALE), 1)) { mn = m_reg; alpha = 1.f; }
    else { mn = fmaxf(m_reg, pmax); alpha = __builtin_amdgcn_exp2f((m_reg - mn) * C); m_reg = mn; }
    float mnC = -mn * C;
#pragma unroll
    for (int r = 0; r < 16; ++r) p0[r] = fmaf(p0[r], C, mnC);
#pragma unroll
    for (int r = 0; r < 16; ++r) p1[r] = fmaf(p1[r], C, mnC);
#pragma unroll
    for (int r = 0; r < 16; ++r) p0[r] = __builtin_amdgcn_exp2f(p0[r]);
}
__device__ __forceinline__ void sm_early2(f32x16& p0, int r, float mC, float& pmax0, bool early) {
    constexpr float C = ATT_SCALE * 1.4426950408889634f;
    pmax0 = fmaxf(fmaxf(pmax0, p0[r]), p0[r + 1]);
    if (early) { p0[r] = __builtin_amdgcn_exp2f(fmaf(p0[r], C, mC)); p0[r + 1] = __builtin_amdgcn_exp2f(fmaf(p0[r + 1], C, mC)); } }
__device__ __forceinline__ void sm_rest(f32x16& p0, f32x16& p1, float pmax0, bool early, float& m_reg, float& mn, float& alpha) {
    constexpr float C = ATT_SCALE * 1.4426950408889634f;
    float pmax = pmax0;
#pragma unroll
    for (int r = 0; r < 16; ++r) pmax = fmaxf(pmax, p1[r]);
    { auto rr = __builtin_amdgcn_permlane32_swap(__float_as_uint(pmax), __float_as_uint(pmax), false, false);
      pmax = fmaxf(__uint_as_float(rr[0]), __uint_as_float(rr[1])); }
    const float m_old = m_reg;
    if (__builtin_expect(__all(pmax - m_reg <= ATT_THR / ATT_SCALE), 1)) { mn = m_reg; alpha = 1.f; }
    else { mn = fmaxf(m_reg, pmax); alpha = __builtin_amdgcn_exp2f((m_reg - mn) * C); m_reg = mn;
        if (early) {
#pragma unroll
            for (int r = 0; r < 16; ++r) p0[r] *= alpha; } }
    float mnC = -mn * C;
    if (!early) {
#pragma unroll
        for (int r = 0; r < 16; ++r) p0[r] = __builtin_amdgcn_exp2f(fmaf(p0[r], C, mnC)); }
#pragma unroll
    for (int r = 0; r < 16; ++r) p1[r] = fmaf(p1[r], C, mnC);
    (void)m_old;
}
__device__ __forceinline__ void finishSM(f32x16& p0, f32x16& p1, float alpha, float& l_reg, bf16x8& pa0, bf16x8& pa1, bf16x8& pa2, bf16x8& pa3) {
#pragma unroll
    for (int r = 0; r < 16; ++r) p1[r] = __builtin_amdgcn_exp2f(p1[r]);
    float ps = 0;
#pragma unroll
    for (int r = 0; r < 16; ++r) ps += p0[r];
#pragma unroll
    for (int r = 0; r < 16; ++r) ps += p1[r];
    { auto rr = __builtin_amdgcn_permlane32_swap(__float_as_uint(ps), __float_as_uint(ps), false, false);
      ps = __uint_as_float(rr[0]) + __uint_as_float(rr[1]); }
    l_reg = l_reg * alpha + ps;
#define PK4(P, BASE, OUT) do { unsigned a0 = cvtpk(P[BASE + 0], P[BASE + 1]), a1 = cvtpk(P[BASE + 2], P[BASE + 3]);   \
    unsigned b0 = cvtpk(P[BASE + 4], P[BASE + 5]), b1 = cvtpk(P[BASE + 6], P[BASE + 7]);                              \
    auto r0 = __builtin_amdgcn_permlane32_swap(a0, b0, false, false); auto r1 = __builtin_amdgcn_permlane32_swap(a1, b1, false, false); \
    u32x4 w = {r0[0], r1[0], r0[1], r1[1]}; OUT = *reinterpret_cast<bf16x8*>(&w); } while (0)
    PK4(p0, 0, pa0); PK4(p0, 8, pa1); PK4(p1, 0, pa2); PK4(p1, 8, pa3);
#undef PK4
}
__device__ __forceinline__ int v_st(int k, int c) { const int kk = (k & ~0xC) | ((k & 4) << 1) | ((k & 8) >> 1); return ((kk >> 3) * 4 + (c >> 5)) * 512 + ((kk & 7) * 32 + (c & 31)) * 2; }
__device__ __forceinline__ int v_rd_base(int lane) { return ((lane & 3) << 3) | (((lane >> 2) & 3) << 6) | (((lane >> 4) & 1) << 5) | (((lane >> 5) & 1) << 8); }
constexpr int v_rd_off(int d0, int ks, int half) { return d0 * 512 + ks * 4096 + half * 2048; }
template <int OFF> __device__ __forceinline__ s16x4 tr_read(int vb) { s16x4 r; asm volatile("ds_read_b64_tr_b16 %0, %1 offset:%2" : "=&v"(r) : "v"(vb), "i"(OFF) : "memory"); return r; }
#define TRV(D0, KS, HF) tr_read<v_rd_off(D0, KS, HF)>(vb)
#define PKV(L, H) (bf16x8){L[0], L[1], L[2], L[3], H[0], H[1], H[2], H[3]}
__device__ __forceinline__ void pv_all(f32x16 (&o)[4], int vb, bf16x8 pa0, bf16x8 pa1, bf16x8 pa2, bf16x8 pa3) {
    s16x4 a0 = TRV(0, 0, 0), a1 = TRV(0, 0, 1), a2 = TRV(0, 1, 0), a3 = TRV(0, 1, 1), a4 = TRV(0, 2, 0), a5 = TRV(0, 2, 1), a6 = TRV(0, 3, 0), a7 = TRV(0, 3, 1);
    s16x4 b0 = TRV(1, 0, 0), b1 = TRV(1, 0, 1), b2 = TRV(1, 1, 0), b3 = TRV(1, 1, 1), b4 = TRV(1, 2, 0), b5 = TRV(1, 2, 1), b6 = TRV(1, 3, 0), b7 = TRV(1, 3, 1);
    asm volatile("s_waitcnt lgkmcnt(8)" ::: "memory"); SBAR();
    o[0] = __builtin_amdgcn_mfma_f32_32x32x16_bf16(PKV(a0, a1), pa0, o[0], 0, 0, 0); SBAR(); a0 = TRV(2, 0, 0); a1 = TRV(2, 0, 1); SBAR();
    o[0] = __builtin_amdgcn_mfma_f32_32x32x16_bf16(PKV(a2, a3), pa1, o[0], 0, 0, 0); SBAR(); a2 = TRV(2, 1, 0); a3 = TRV(2, 1, 1); SBAR();
    o[0] = __builtin_amdgcn_mfma_f32_32x32x16_bf16(PKV(a4, a5), pa2, o[0], 0, 0, 0); SBAR(); a4 = TRV(2, 2, 0); a5 = TRV(2, 2, 1); SBAR();
    o[0] = __builtin_amdgcn_mfma_f32_32x32x16_bf16(PKV(a6, a7), pa3, o[0], 0, 0, 0); SBAR(); a6 = TRV(2, 3, 0); a7 = TRV(2, 3, 1);
    asm volatile("s_waitcnt lgkmcnt(8)" ::: "memory"); SBAR();
    o[1] = __builtin_amdgcn_mfma_f32_32x32x16_bf16(PKV(b0, b1), pa0, o[1], 0, 0, 0); SBAR(); b0 = TRV(3, 0, 0); b1 = TRV(3, 0, 1); SBAR();
    o[1] = __builtin_amdgcn_mfma_f32_32x32x16_bf16(PKV(b2, b3), pa1, o[1], 0, 0, 0); SBAR(); b2 = TRV(3, 1, 0); b3 = TRV(3, 1, 1); SBAR();
    o[1] = __builtin_amdgcn_mfma_f32_32x32x16_bf16(PKV(b4, b5), pa2, o[1], 0, 0, 0); SBAR(); b4 = TRV(3, 2, 0); b5 = TRV(3, 2, 1); SBAR();
    o[1] = __builtin_amdgcn_mfma_f32_32x32x16_bf16(PKV(b6, b7), pa3, o[1], 0, 0, 0); SBAR(); b6 = TRV(3, 3, 0); b7 = TRV(3, 3, 1);
    asm volatile("s_waitcnt lgkmcnt(8)" ::: "memory"); SBAR();
    o[2] = __builtin_amdgcn_mfma_f32_32x32x16_bf16(PKV(a0, a1), pa0, o[2], 0, 0, 0); o[2] = __builtin_amdgcn_mfma_f32_32x32x16_bf16(PKV(a2, a3), pa1, o[2], 0, 0, 0);
    o[2] = __builtin_amdgcn_mfma_f32_32x32x16_bf16(PKV(a4, a5), pa2, o[2], 0, 0, 0); o[2] = __builtin_amdgcn_mfma_f32_32x32x16_bf16(PKV(a6, a7), pa3, o[2], 0, 0, 0);
    asm volatile("s_waitcnt lgkmcnt(0)" ::: "memory"); SBAR();
    o[3] = __builtin_amdgcn_mfma_f32_32x32x16_bf16(PKV(b0, b1), pa0, o[3], 0, 0, 0); o[3] = __builtin_amdgcn_mfma_f32_32x32x16_bf16(PKV(b2, b3), pa1, o[3], 0, 0, 0);
    o[3] = __builtin_amdgcn_mfma_f32_32x32x16_bf16(PKV(b4, b5), pa2, o[3], 0, 0, 0); o[3] = __builtin_amdgcn_mfma_f32_32x32x16_bf16(PKV(b6, b7), pa3, o[3], 0, 0, 0);
}
#undef TRV
#undef PKV
__device__ void attn_unit(const bf16_t* __restrict__ Qb, const bf16_t* __restrict__ Kn, const bf16_t* __restrict__ Vh, const bf16_t* __restrict__ Kr, bf16_t* Og, int nkeys, char* lds, int dry = 0) {
    int tid_ = threadIdx.x; asm volatile("" : "+v"(tid_)); const int tid = tid_, wid = tid >> 6, lane = tid & 63, r32 = lane & 31, hi = lane >> 5;
    char* V_lds = lds; char* K_lds = lds + 3 * SHM_V; char* R_lds = K_lds + 3 * SHM_K;
    float* wsx = (float*)(R_lds + 3 * SHM_R) + wid * 64; float* li_l = wsx; float* al_l = wsx + 32;
    float m_reg = -1e30f, l_reg = 0.f; f32x16 o[4];
#pragma unroll
    for (int d = 0; d < 4; ++d)
#pragma unroll
        for (int r = 0; r < 16; ++r) o[d][r] = 0.f;
    bf16x8 qr[12];
    { const bf16_t* Qw = Qb + (size_t)(wid * 32 + r32) * QW + hi * 8;
#pragma unroll
      for (int d0 = 0; d0 < 12; ++d0) qr[d0] = *(const bf16x8*)(Qw + d0 * 16); }
    const int lag = __builtin_amdgcn_readfirstlane(wid >> 2);
    const int iw = (wid & 3);
    const int iwu = __builtin_amdgcn_readfirstlane(iw);
    int offK[4], offV[4], offR[2];
#pragma unroll
    for (int i = 0; i < 4; ++i) { int pc = 4 * iw + i; int row = 4 * pc + (lane >> 4); offK[i] = row * KVW + (((lane & 15) ^ (row & 15)) << 3);
        int L = pc * 1024 + lane * 16; int st = L >> 9, e = (L & 511) >> 1; int kk = (st >> 2) * 8 + (e >> 5), c = (st & 3) * 32 + (e & 31); int k = (kk & ~0xC) | ((kk & 4) << 1) | ((kk & 8) >> 1);
        offV[i] = k * KVW + c; }
#pragma unroll
    for (int i = 0; i < 2; ++i) { int row = 8 * (2 * iw + i) + (lane >> 3); offR[i] = row * 64 + (((lane & 7) ^ RSWZF(row)) << 3); }
#define AT_DMA(sbase, voff, dst) asm volatile("s_mov_b32 m0, %2\n\ts_nop 0\n\tglobal_load_lds_dwordx4 %0, %1" :: "v"(voff), "s"(sbase), "s"((unsigned)(uintptr_t)(dst)) : "memory", "m0")
#define AT_ISSUE(t) do { const int b_ = (t) % 3; const size_t kb_ = (size_t)(t) * 64; \
        const char* kb2_ = (const char*)(Kn + kb_ * KVW); const char* vb2_ = (const char*)(Vh + kb_ * KVW); const char* rb2_ = (const char*)(Kr + kb_ * 64); \
        _Pragma("unroll") for (int i_ = 0; i_ < 4; ++i_) { \
            AT_DMA(kb2_, (unsigned)(offK[i_] * 2), K_lds + b_ * SHM_K + (4 * iwu + i_) * 1024); \
            AT_DMA(vb2_, (unsigned)(offV[i_] * 2), V_lds + b_ * SHM_V + (4 * iwu + i_) * 1024); } \
        _Pragma("unroll") for (int i_ = 0; i_ < 2; ++i_) \
            AT_DMA(rb2_, (unsigned)(offR[i_] * 2), R_lds + b_ * SHM_R + (2 * iwu + i_) * 1024); } while (0)
#define AT_BAR() do { asm volatile("" ::: "memory"); __builtin_amdgcn_s_barrier(); asm volatile("" ::: "memory"); } while (0)
    const int vb0 = (int)(uintptr_t)V_lds + v_rd_base(lane);
    const int NT = nkeys / 64;
    __syncthreads();
    if (lag) { AT_ISSUE(0); AT_ISSUE(1); AT_ISSUE(2); asm volatile("s_waitcnt vmcnt(20)" ::: "memory"); }
    AT_BAR();
    if (lag) AT_BAR();
    int bj = 0;
    for (int j = 0; j < NT; ++j) {
#define AT_TOP_ODD() do { if (j >= 1 && j + 2 < NT) AT_ISSUE(j + 2); } while (0)
#define AT_END_ODD() do { if (j + 1 < NT) { if (j + 2 < NT) asm volatile("s_waitcnt vmcnt(10)" ::: "memory"); else asm volatile("s_waitcnt vmcnt(0)" ::: "memory"); } } while (0)
        if (lag) AT_TOP_ODD();
        f32x16 p0, p1; float pmax0 = -3.0e38f; const bool early_j = j > 0;
#pragma unroll
        for (int r = 0; r < 16; ++r) { p0[r] = 0.f; p1[r] = 0.f; }
        {
          const int kb0 = (int)(uintptr_t)(K_lds + bj * SHM_K) + r32 * 256 + ((hi ^ (r32 & 15)) << 4);
          const int rb0 = (int)(uintptr_t)(R_lds + bj * SHM_R) + r32 * 128 + ((hi ^ RSWZF(r32)) << 4);
#define KRD(dst, addr, OFF) asm volatile("ds_read_b128 %0, %1 offset:%2" : "=v"(dst) : "v"(addr), "i"(OFF) : "memory")
#define KADDR(d0_) ((d0_) < 8 ? (kb0 ^ ((d0_) << 5)) : (rb0 ^ (((d0_) - 8) << 5)))
#define KISSUE(A_, B_, d0_) do { const int ad_ = KADDR(d0_); if ((d0_) < 8) { KRD(A_, ad_, 0); KRD(B_, ad_, 8192); } else { KRD(A_, ad_, 0); KRD(B_, ad_, 4096); } } while (0)
#define KRDH(dst, hs_) do { if ((hs_) < 12) KRD(dst, KADDR(hs_), 0); else if ((hs_) - 12 < 8) KRD(dst, KADDR((hs_) - 12), 8192); else KRD(dst, KADDR((hs_) - 12), 4096); } while (0)
          bf16x8 f0, f1, f2, f3;
          KRDH(f0, 0); KRDH(f1, 1); KRDH(f2, 2); KRDH(f3, 3);
          const bool early = j > 0; const float mCe = -m_reg * (ATT_SCALE * 1.4426950408889634f);
#define HSTEP(F_, hs_) do { \
              if ((hs_) <= 20) asm volatile("s_waitcnt lgkmcnt(3)" ::: "memory"); else if ((hs_) == 21) asm volatile("s_waitcnt lgkmcnt(2)" ::: "memory"); \
              else if ((hs_) == 22) asm volatile("s_waitcnt lgkmcnt(1)" ::: "memory"); else asm volatile("s_waitcnt lgkmcnt(0)" ::: "memory"); \
              SBAR(); \
              if ((hs_) < 12) p0 = __builtin_amdgcn_mfma_f32_32x32x16_bf16(F_, qr[(hs_) % 12], p0, 0, 0, 0); else p1 = __builtin_amdgcn_mfma_f32_32x32x16_bf16(F_, qr[(hs_) % 12], p1, 0, 0, 0); \
              SBAR(); \
              if ((hs_) + 4 < 24) KRDH(F_, (hs_) + 4); \
              if ((hs_) >= 14 && (hs_) < 22) { sm_early2(p0, 2 * ((hs_) - 14), mCe, pmax0, early); SBAR(); } } while (0)
          HSTEP(f0, 0); HSTEP(f1, 1); HSTEP(f2, 2); HSTEP(f3, 3); HSTEP(f0, 4); HSTEP(f1, 5); HSTEP(f2, 6); HSTEP(f3, 7); HSTEP(f0, 8); HSTEP(f1, 9); HSTEP(f2, 10); HSTEP(f3, 11);
          HSTEP(f0, 12); HSTEP(f1, 13); HSTEP(f2, 14); HSTEP(f3, 15); HSTEP(f0, 16); HSTEP(f1, 17); HSTEP(f2, 18); HSTEP(f3, 19); HSTEP(f0, 20); HSTEP(f1, 21); HSTEP(f2, 22); HSTEP(f3, 23);
#undef HSTEP
#undef KRDH
#define QSTEP_UNUSED
#undef QSTEP_UNUSED
#undef KISSUE
#undef KADDR
#undef KRD
        }
        float mn, alpha;
        sm_rest(p0, p1, pmax0, early_j, m_reg, mn, alpha); SBAR();
        if (lag) AT_END_ODD();
        AT_BAR();
        if (__any(alpha < 1.f)) {
#pragma unroll
            for (int d = 0; d < 4; ++d)
#pragma unroll
                for (int r = 0; r < 16; ++r) o[d][r] *= alpha; }
        bf16x8 pa0, pa1, pa2, pa3;
        finishSM(p0, p1, alpha, l_reg, pa0, pa1, pa2, pa3); SBAR();
        pv_all(o, vb0 + bj * SHM_V, pa0, pa1, pa2, pa3);
        AT_BAR();
        bj = bj == 2 ? 0 : bj + 1;
    }
    if (!lag) AT_BAR();
#undef AT_TOP_ODD
#undef AT_END_ODD
#undef AT_ISSUE
#undef AT_DMA
#undef AT_BAR
    const float rl = 1.0f / l_reg;
    bf16_t* Ow = Og + (size_t)(wid * 32 + r32) * 1024 + hi * 8;
    u32x4 gq[4][2];
#pragma unroll
    for (int d0 = 0; d0 < 4; ++d0)
#pragma unroll
        for (int pp = 0; pp < 2; ++pp) gq[d0][pp] = __builtin_nontemporal_load((const u32x4*)(Ow + d0 * 32 + 16 * pp));
#pragma unroll
    for (int d0 = 0; d0 < 4; ++d0)
#pragma unroll
        for (int pp = 0; pp < 2; ++pp) { const u32x4 gw = gq[d0][pp];
            auto g02 = __builtin_amdgcn_permlane32_swap(gw[0], gw[2], false, false); auto g13 = __builtin_amdgcn_permlane32_swap(gw[1], gw[3], false, false);
            const unsigned ga0 = g02[0], ga1 = g13[0], gb0 = g02[1], gb1 = g13[1];
            const int ra = 8 * pp, rb = 8 * pp + 4;
            const unsigned a0 = cvtpk(o[d0][ra + 0] * rl * __uint_as_float(ga0 << 16), o[d0][ra + 1] * rl * __uint_as_float(ga0 & 0xffff0000u));
            const unsigned a1 = cvtpk(o[d0][ra + 2] * rl * __uint_as_float(ga1 << 16), o[d0][ra + 3] * rl * __uint_as_float(ga1 & 0xffff0000u));
            const unsigned b0 = cvtpk(o[d0][rb + 0] * rl * __uint_as_float(gb0 << 16), o[d0][rb + 1] * rl * __uint_as_float(gb0 & 0xffff0000u));
            const unsigned b1 = cvtpk(o[d0][rb + 2] * rl * __uint_as_float(gb1 << 16), o[d0][rb + 3] * rl * __uint_as_float(gb1 & 0xffff0000u));
            auto s0 = __builtin_amdgcn_permlane32_swap(a0, b0, false, false); auto s1 = __builtin_amdgcn_permlane32_swap(a1, b1, false, false);
            const u32x4 w = {s0[0], s1[0], s0[1], s1[1]};
            if (!dry) *(u32x4*)(Ow + d0 * 32 + 16 * pp) = w; else asm volatile("" :: "v"(w)); }
}
__device__ void phase_attn(const Params& p, bool with_ctx, char* smem, bool dry = false) {
    char* ws = p.ws; const bf16_t* Q = (const bf16_t*)p.xout; const bf16_t* KV = (const bf16_t*)(ws + O_KV); const bf16_t* KR = (const bf16_t*)(ws + O_KR); bf16_t* MSG = (bf16_t*)(ws + O_MSG);
    const int h = blockIdx.x & 7, jw = blockIdx.x >> 3, nj = gridDim.x >> 3;
    const int nunits = 64 + (with_ctx ? 8 : 0);
    for (int lu = jw; lu < nunits; lu += nj) {
        int b, s0, nkeys;
        if (lu < 64) { b = lu >> 3; s0 = CTX + (lu & 7) * 256; nkeys = SALL; } else { b = lu - 64; s0 = 0; nkeys = CTX; }
        size_t rb = (size_t)b * SALL;
        attn_unit(Q + (rb + s0) * QW + h * 192, KV + rb * KVW + h * 256, KV + rb * KVW + h * 256 + 128, KR + rb * 64, MSG + (rb + s0) * 1024 + h * 128, nkeys, smem, dry);
    }
}


__device__ void phase_conv(const Params& p, int e) {
    int tid_ = threadIdx.x; asm volatile("" : "+v"(tid_)); const int tid = tid_;
    const bf16_t* XA = (const bf16_t*)p.xout; bf16_t* U = (bf16_t*)(p.ws + E_N);
    const float* cwp = p.in[8] + (size_t)e * 4 * 1024; const float* cbp = p.in[9] + e * 1024;
    const int gt = blockIdx.x * NTHR + tid, nthreads = gridDim.x * NTHR;
    const int c8 = (gt & 127) * 8; const int nruns = nthreads >> 7; const int rows_per = (NTOK + nruns - 1) / nruns;
    float w[4][8], bias[8];
#pragma unroll
    for (int k = 0; k < 4; ++k) { f32x4 w0 = *(const f32x4*)(cwp + k * 1024 + c8), w1 = *(const f32x4*)(cwp + k * 1024 + c8 + 4);
#pragma unroll
        for (int j = 0; j < 4; ++j) { w[k][j] = w0[j]; w[k][4 + j] = w1[j]; } }
    { f32x4 c0 = *(const f32x4*)(cbp + c8), c1 = *(const f32x4*)(cbp + c8 + 4);
#pragma unroll
      for (int j = 0; j < 4; ++j) { bias[j] = c0[j]; bias[4 + j] = c1[j]; } }
    const int r0 = (gt >> 7) * rows_per; const int r1 = (r0 + rows_per < NTOK) ? r0 + rows_per : NTOK;
    for (int rg = r0; rg < r1; rg += 6) {
        uint4 xv[9];
#pragma unroll
        for (int i = 0; i < 9; ++i) { int rr = rg - 2 + i; rr = rr < 0 ? 0 : (rr >= NTOK ? NTOK - 1 : rr); xv[i] = *(const uint4*)(XA + (size_t)rr * 1024 + c8); }
#pragma unroll
        for (int o6 = 0; o6 < 6; ++o6) { const int r = rg + o6; if (r >= r1) break;
            int b = r / SALL, s = r - b * SALL; int qlo = s < CTX ? 0 : CTX, qhi = s < CTX ? CTX : SALL;
            float acc[8];
#pragma unroll
            for (int j = 0; j < 8; ++j) acc[j] = bias[j];
#pragma unroll
            for (int k = 0; k < 4; ++k) { int s2 = s + k - 2; const uint4 x = xv[o6 + k]; const float m = (s2 >= qlo && s2 < qhi) ? 1.f : 0.f;
                acc[0] += m * w[k][0] * __uint_as_float(x.x << 16); acc[1] += m * w[k][1] * __uint_as_float(x.x & 0xffff0000u); acc[2] += m * w[k][2] * __uint_as_float(x.y << 16); acc[3] += m * w[k][3] * __uint_as_float(x.y & 0xffff0000u);
                acc[4] += m * w[k][4] * __uint_as_float(x.z << 16); acc[5] += m * w[k][5] * __uint_as_float(x.z & 0xffff0000u); acc[6] += m * w[k][6] * __uint_as_float(x.w << 16); acc[7] += m * w[k][7] * __uint_as_float(x.w & 0xffff0000u); }
            uint4 o; o.x = cvtpk(acc[0], acc[1]); o.y = cvtpk(acc[2], acc[3]); o.z = cvtpk(acc[4], acc[5]); o.w = cvtpk(acc[6], acc[7]);
            *(uint4*)(U + (size_t)r * 1024 + c8) = o; } }
}
template <int CTRL> __device__ __forceinline__ float dpp_f(float v, float ident) { return __int_as_float(__builtin_amdgcn_update_dpp(__float_as_int(ident), __float_as_int(v), CTRL, 0xf, 0xf, false)); }
constexpr int LRU_TOK = 128, LRU_D = 2, LRU_R = 3, LRU_SLOT = 49152, LRU_NS = SALL / LRU_TOK;
constexpr int LRU_TOT = LRU_R * LRU_SLOT;
constexpr int LRU_CAR = LRU_TOT + 4 * 8 * 4 * 2 * 8;
static_assert(LRU_CAR + 2 * 4 * 4 * 2 * 4 <= SMEM_BYTES - 16, "lru lds");
__device__ __forceinline__ int lru_chain_s(int d, int i) { return d == 0 ? i : (i < CTX ? CTX - 1 - i : SALL - 1 - (i - CTX)); }
__device__ void lru_item(const Params& p, int e, int b, int h, int q4, char* lds, int dry) {
    int tid_ = threadIdx.x; asm volatile("" : "+v"(tid_)); const int tid = tid_;
    const int wid = __builtin_amdgcn_readfirstlane(tid >> 6), lane = tid & 63, fr = lane & 15, fq = lane >> 4;
    char* ws = p.ws;
    const bf16_t* U = (const bf16_t*)(ws + E_N); bf16_t* HF = (bf16_t*)p.xout; bf16_t* MRG = (bf16_t*)(ws + E_MRG);
    const bf16_t* WL = (const bf16_t*)(ws + OFF_WBF) + e * WE_SZ + WE_LRU + (size_t)h * 512 * 128;
    const size_t rb = (size_t)b * SALL;
    const bool loader = wid >= 4; const int lw = wid & 3, th = wid >> 2;
    const int c8 = q4 * 32 + lw * 8;
    const int che = (fq & 1) * 4 + (fq >> 1) * 2;
    const int chg = h * 128 + c8 + che;
    float2* TOT = (float2*)(lds + LRU_TOT) + lw * 64;
    float* CAR = (float*)(lds + LRU_CAR) + lw * 8;
    for (int d = 0; d < 2; ++d) {
        bf16x8 wfr[4]; f32x4 binit; float sp8[2];
        { int gate = fr >> 3; const bf16_t* wrow = WL + (size_t)((d * 2 + gate) * 128 + c8 + (fr & 7)) * 128 + fq * 8;
#pragma unroll
          for (int ks = 0; ks < 4; ++ks) wfr[ks] = *(const bf16x8*)(wrow + ks * 32);
          const float* bp = p.in[fq < 2 ? 11 : 13] + (e * 2 + d) * 1024 + h * 128 + c8 + (fq & 1) * 4;
#pragma unroll
          for (int j = 0; j < 4; ++j) binit[j] = -1.4426950408889634f * bp[j];
#pragma unroll
          for (int j = 0; j < 2; ++j) { float lam = p.in[14][(e * 2 + d) * 1024 + chg + j]; sp8[j] = -8.f * log1pf(expf(-lam)) * 1.4426950408889634f; } }
        if (fr == 15) { CAR[fq * 2] = 0.f; CAR[fq * 2 + 1] = 0.f; }
#define LRU_ISSUE(s_) do { char* slot_ = lds + ((s_) % LRU_R) * LRU_SLOT; \
            _Pragma("unroll") for (int i_ = 0; i_ < 4; ++i_) { int trow_ = 16 * wid + 4 * i_ + (lane >> 4); size_t grow_ = rb + lru_chain_s(d, (s_) * LRU_TOK + trow_); \
                __builtin_amdgcn_global_load_lds((const unsigned*)(U + grow_ * 1024 + h * 128 + (((lane & 15) ^ (trow_ & 15)) << 3)), (__attribute__((address_space(3))) unsigned*)(slot_ + (4 * wid + i_) * 1024), 16, 0, 0); } \
            if (d == 1) { size_t gr2_ = rb + lru_chain_s(d, (s_) * LRU_TOK + 16 * wid + (lane >> 2)); \
                __builtin_amdgcn_global_load_lds((const unsigned*)(HF + gr2_ * 1024 + h * 128 + q4 * 32 + (lane & 3) * 8), (__attribute__((address_space(3))) unsigned*)(slot_ + 32768 + wid * 1024), 16, 0, 16); \
                __builtin_amdgcn_global_load_lds((const unsigned*)(MRG + gr2_ * 1536 + h * 128 + q4 * 32 + (lane & 3) * 8), (__attribute__((address_space(3))) unsigned*)(slot_ + 40960 + wid * 1024), 16, 0, 0); } } while (0)
#define LRU_WAIT() do { if (d == 1) asm volatile("s_waitcnt vmcnt(6)" ::: "memory"); else asm volatile("s_waitcnt vmcnt(4)" ::: "memory"); } while (0)
        { for (int s = 0; s < LRU_D; ++s) LRU_ISSUE(s); LRU_WAIT(); }
        asm volatile("" ::: "memory"); __builtin_amdgcn_s_barrier(); asm volatile("" ::: "memory");
        for (int k = 0; k < LRU_NS; ++k) {
            if (k + LRU_D < LRU_NS && dry != 2) LRU_ISSUE(k + LRU_D);
            const char* slot = lds + (k % LRU_R) * LRU_SLOT;
            float av[4][2], bv[4][2]; unsigned hfv[4], gv[4];
            if (dry >= 10) {
#pragma unroll
                for (int mi = 0; mi < 4; ++mi) { av[mi][0] = 0.5f; av[mi][1] = 0.5f; bv[mi][0] = 1.f; bv[mi][1] = 1.f; hfv[mi] = 0u; gv[mi] = 0u; } }
            else {
#pragma unroll
            for (int mi = 0; mi < 4; ++mi) { const int mf = 4 * th + mi; const char* rowp = slot + (16 * mf + fr) * 256;
                bf16x8 af0 = *(const bf16x8*)(rowp + (((0 + fq) ^ fr) << 4)), af1 = *(const bf16x8*)(rowp + (((4 + fq) ^ fr) << 4));
                bf16x8 af2 = *(const bf16x8*)(rowp + (((8 + fq) ^ fr) << 4)), af3 = *(const bf16x8*)(rowp + (((12 + fq) ^ fr) << 4));
                const unsigned cu2 = *(const unsigned*)(rowp + (((c8 >> 3) ^ fr) << 4) + che * 2);
                hfv[mi] = 0u; gv[mi] = 0u;
                if (d == 1) { hfv[mi] = *(const unsigned*)(slot + 32768 + (16 * mf + fr) * 64 + (lw * 8 + che) * 2); gv[mi] = *(const unsigned*)(slot + 40960 + (16 * mf + fr) * 64 + (lw * 8 + che) * 2); }
                f32x4 acc = binit;
                acc = __builtin_amdgcn_mfma_f32_16x16x32_bf16(wfr[0], af0, acc, 0, 0, 0);
                acc = __builtin_amdgcn_mfma_f32_16x16x32_bf16(wfr[1], af1, acc, 0, 0, 0);
                acc = __builtin_amdgcn_mfma_f32_16x16x32_bf16(wfr[2], af2, acc, 0, 0, 0);
                acc = __builtin_amdgcn_mfma_f32_16x16x32_bf16(wfr[3], af3, acc, 0, 0, 0);
                auto s0 = __builtin_amdgcn_permlane32_swap(__float_as_uint(acc[0]), __float_as_uint(acc[2]), false, false);
                auto s1 = __builtin_amdgcn_permlane32_swap(__float_as_uint(acc[1]), __float_as_uint(acc[3]), false, false);
                float zr0 = __uint_as_float(s0[0]), zi0 = __uint_as_float(s0[1]), zr1 = __uint_as_float(s1[0]), zi1 = __uint_as_float(s1[1]);
                float r0 = __builtin_amdgcn_rcpf(1.f + __builtin_amdgcn_exp2f(zr0)), i0 = __builtin_amdgcn_rcpf(1.f + __builtin_amdgcn_exp2f(zi0));
                float r1 = __builtin_amdgcn_rcpf(1.f + __builtin_amdgcn_exp2f(zr1)), i1 = __builtin_amdgcn_rcpf(1.f + __builtin_amdgcn_exp2f(zi1));
                float a0 = __builtin_amdgcn_exp2f(r0 * sp8[0]), a1 = __builtin_amdgcn_exp2f(r1 * sp8[1]);
                av[mi][0] = a0; av[mi][1] = a1;
                bv[mi][0] = __builtin_amdgcn_sqrtf(fmaf(-a0, a0, 1.f)) * (i0 * __uint_as_float(cu2 << 16));
                bv[mi][1] = __builtin_amdgcn_sqrtf(fmaf(-a1, a1, 1.f)) * (i1 * __uint_as_float(cu2 & 0xffff0000u)); }
#define LRU_SCAN(N) asm volatile("s_nop 1\n\t" \
                "v_fmac_f32_dpp %0, %0, %8 row_shr:" #N " row_mask:0xf bank_mask:0xf\n\tv_fmac_f32_dpp %1, %1, %9 row_shr:" #N " row_mask:0xf bank_mask:0xf\n\t" \
                "v_fmac_f32_dpp %2, %2, %10 row_shr:" #N " row_mask:0xf bank_mask:0xf\n\tv_fmac_f32_dpp %3, %3, %11 row_shr:" #N " row_mask:0xf bank_mask:0xf\n\t" \
                "v_fmac_f32_dpp %4, %4, %12 row_shr:" #N " row_mask:0xf bank_mask:0xf\n\tv_fmac_f32_dpp %5, %5, %13 row_shr:" #N " row_mask:0xf bank_mask:0xf\n\t" \
                "v_fmac_f32_dpp %6, %6, %14 row_shr:" #N " row_mask:0xf bank_mask:0xf\n\tv_fmac_f32_dpp %7, %7, %15 row_shr:" #N " row_mask:0xf bank_mask:0xf\n\t" \
                "v_mul_f32_dpp %8, %8, %8 row_shr:" #N " row_mask:0xf bank_mask:0xf\n\tv_mul_f32_dpp %9, %9, %9 row_shr:" #N " row_mask:0xf bank_mask:0xf\n\t" \
                "v_mul_f32_dpp %10, %10, %10 row_shr:" #N " row_mask:0xf bank_mask:0xf\n\tv_mul_f32_dpp %11, %11, %11 row_shr:" #N " row_mask:0xf bank_mask:0xf\n\t" \
                "v_mul_f32_dpp %12, %12, %12 row_shr:" #N " row_mask:0xf bank_mask:0xf\n\tv_mul_f32_dpp %13, %13, %13 row_shr:" #N " row_mask:0xf bank_mask:0xf\n\t" \
                "v_mul_f32_dpp %14, %14, %14 row_shr:" #N " row_mask:0xf bank_mask:0xf\n\tv_mul_f32_dpp %15, %15, %15 row_shr:" #N " row_mask:0xf bank_mask:0xf\n\ts_nop 1" \
                : "+v"(bv[0][0]), "+v"(bv[0][1]), "+v"(bv[1][0]), "+v"(bv[1][1]), "+v"(bv[2][0]), "+v"(bv[2][1]), "+v"(bv[3][0]), "+v"(bv[3][1]), \
                  "+v"(av[0][0]), "+v"(av[0][1]), "+v"(av[1][0]), "+v"(av[1][1]), "+v"(av[2][0]), "+v"(av[2][1]), "+v"(av[3][0]), "+v"(av[3][1]))
            LRU_SCAN(1); LRU_SCAN(2); LRU_SCAN(4); LRU_SCAN(8);
            }
#undef LRU_SCAN
            if (fr == 15 && dry != 11) {
#pragma unroll
                for (int mi = 0; mi < 4; ++mi) { TOT[((4 * th + mi) * 4 + fq) * 2 + 0] = make_float2(av[mi][0], bv[mi][0]); TOT[((4 * th + mi) * 4 + fq) * 2 + 1] = make_float2(av[mi][1], bv[mi][1]); } }
            if (k + LRU_D < LRU_NS) LRU_WAIT(); else asm volatile("s_waitcnt vmcnt(0)" ::: "memory");
            asm volatile("s_waitcnt lgkmcnt(0)" ::: "memory");
            asm volatile("" ::: "memory"); __builtin_amdgcn_s_barrier(); asm volatile("" ::: "memory");
            float hin0 = CAR[(k & 1) * 32 + fq * 2], hin1 = CAR[(k & 1) * 32 + fq * 2 + 1];
            for (int sg = 0; sg < 4 * th; ++sg) { float2 t0 = TOT[(sg * 4 + fq) * 2], t1 = TOT[(sg * 4 + fq) * 2 + 1]; hin0 = fmaf(t0.x, hin0, t0.y); hin1 = fmaf(t1.x, hin1, t1.y); }
            const size_t crow0 = rb + lru_chain_s(d, k * LRU_TOK + 64 * th + fr); const long dstep = (d == 0 ? 16 : -16);
#pragma unroll
            for (int mi = 0; mi < 4; ++mi) {
                float h0 = fmaf(av[mi][0], hin0, bv[mi][0]), h1 = fmaf(av[mi][1], hin1, bv[mi][1]);
                { float2 t0 = TOT[((4 * th + mi) * 4 + fq) * 2], t1 = TOT[((4 * th + mi) * 4 + fq) * 2 + 1]; hin0 = fmaf(t0.x, hin0, t0.y); hin1 = fmaf(t1.x, hin1, t1.y); }
                const size_t crow = crow0 + mi * dstep;
                if (d == 0) { if (dry != 4 && dry != 11) *(unsigned*)(HF + crow * 1024 + chg) = cvtpk(h0, h1); else asm volatile("" :: "v"(h0), "v"(h1)); }
                else { float y0 = (h0 + __uint_as_float(hfv[mi] << 16)) * __uint_as_float(gv[mi] << 16), y1 = (h1 + __uint_as_float(hfv[mi] & 0xffff0000u)) * __uint_as_float(gv[mi] & 0xffff0000u);
                    if (dry == 0) *(unsigned*)(MRG + crow * 1536 + chg) = cvtpk(y0, y1); else asm volatile("" :: "v"(y0), "v"(y1)); } }
            if (th == 1 && fr == 15) { CAR[((k + 1) & 1) * 32 + fq * 2] = hin0; CAR[((k + 1) & 1) * 32 + fq * 2 + 1] = hin1; }
            asm volatile("s_waitcnt lgkmcnt(0)" ::: "memory");
            asm volatile("" ::: "memory"); __builtin_amdgcn_s_barrier(); asm volatile("" ::: "memory");
        }
#undef LRU_ISSUE
#undef LRU_WAIT
        asm volatile("s_waitcnt vmcnt(0)" ::: "memory");
        asm volatile("" ::: "memory"); __builtin_amdgcn_s_barrier(); asm volatile("" ::: "memory");
    }
}
__device__ void phase_lru(const Params& p, int e, char* smem, int dry = 0) {
    __syncthreads();
    const int xcd = blockIdx.x & 7, j = blockIdx.x >> 3, nj = gridDim.x >> 3;
    for (int q = j; q < 32; q += nj) { int pair = xcd * 8 + (q >> 2); lru_item(p, e, pair >> 3, pair & 7, q & 3, smem, dry); }
}

constexpr size_t T_MM = 0, T_NM = 8388608, T_KS = 16777216, T_AP = T_KS + 1032192;
static_assert(T_AP + 32768 <= SZ_TAB, "tab");
__device__ void phase_s5_tables(const Params& p, int e, char* smem) {
    int tid_ = threadIdx.x; asm volatile("" : "+v"(tid_)); const int tid = tid_;
    float2* pw = (float2*)smem;
    float2* bb = pw + 33 * 64;
    float2* cc = bb + 64 * 16;
    float* k0 = (float*)(cc + 16 * 64);
    bf16_t* MM = (bf16_t*)(p.ws + OFF_TAB + T_MM); bf16_t* NM = (bf16_t*)(p.ws + OFF_TAB + T_NM); bf16_t* KS = (bf16_t*)(p.ws + OFF_TAB + T_KS); float2* AP = (float2*)(p.ws + OFF_TAB + T_AP);
    for (int it = blockIdx.x; it < 32 * 8; it += gridDim.x) { const int g = it >> 3, part = it & 7;
        for (int d = 0; d < 2; ++d) {
            __syncthreads();
            if (tid < 64) { int pp = tid; size_t gp = ((size_t)(e * 2 + d) * 32 + g) * 64 + pp;
                float lre = p.in[15][gp], lim = p.in[16][gp], dt = expf(p.in[17][gp]);
                float mag = expf(lre * dt), are = mag * cosf(lim * dt), aim = mag * sinf(lim * dt);
                float den = lre * lre + lim * lim, nr = are - 1.f;
                float fre = (nr * lre + aim * lim) / den, fim = (aim * lre - nr * lim) / den;
                for (int hh = 0; hh < 16; ++hh) { float br = p.in[18][gp * 16 + hh], bi = p.in[19][gp * 16 + hh]; bb[pp * 16 + hh] = make_float2(fre * br - fim * bi, fre * bi + fim * br); }
                double ar = are, ai = aim, pr = 1.0, pi = 0.0;
                for (int n = 0; n <= 32; ++n) { pw[n * 64 + pp] = make_float2((float)pr, (float)pi); double t = pr * ar - pi * ai; pi = pr * ai + pi * ar; pr = t; }
                if (part == 0) AP[(g * 2 + d) * 64 + pp] = pw[32 * 64 + pp]; }
            for (int i = tid; i < 1024; i += NTHR) { size_t ci = (((size_t)(e * 2 + d) * 32 + g) * 16) * 64 + i; cc[i] = make_float2(p.in[20][ci], p.in[21][ci]); }
            __syncthreads();
            bf16_t* mm = MM + (size_t)(g * 2 + d) * 128 * 512;
            for (int i = part * 8192 + tid; i < part * 8192 + 8192; i += NTHR) { int n = i >> 9, k = i & 511, pp = n & 63, im = n >> 6, tau = k >> 4, hh = k & 15;
                float2 w = d == 0 ? pw[(31 - tau) * 64 + pp] : pw[tau * 64 + pp]; float2 b2 = bb[pp * 16 + hh];
                float v = im ? (w.x * b2.y + w.y * b2.x) : (w.x * b2.x - w.y * b2.y); mm[i] = f2bf(v); }
            for (int i = part * 8192 + tid; i < part * 8192 + 8192; i += NTHR) { int n = i >> 7, kk = i & 127, tau = n >> 4, hh = n & 15, pp = kk & 63, im = kk >> 6;
                float2 w = d == 0 ? pw[(tau + 1) * 64 + pp] : pw[(32 - tau) * 64 + pp]; float2 c2 = cc[hh * 64 + pp];
                float zr = c2.x * w.x - c2.y * w.y, zi = c2.x * w.y + c2.y * w.x; NM[((size_t)g * 512 + n) * 256 + d * 128 + kk] = f2bf(im ? -zi : zr); }
            for (int i = part * 1024 + tid; i < part * 1024 + 1024; i += NTHR) { int lag = i >> 8, ho = (i >> 4) & 15, hi_ = i & 15; float s = 0.f;
                for (int pp = 0; pp < 64; ++pp) { float2 c2 = cc[ho * 64 + pp], w = pw[lag * 64 + pp], b2 = bb[pp * 16 + hi_]; float zr = c2.x * w.x - c2.y * w.y, zi = c2.x * w.y + c2.y * w.x; s += zr * b2.x - zi * b2.y; }
                if (lag == 0) { if (d == 0) k0[i] = s + (ho == hi_ ? p.in[22][(e * 32 + g) * 16 + ho] : 0.f); else KS[((size_t)g * 63 + 31) * 256 + i] = f2bf(k0[i] + s); }
                else { int di = d == 0 ? 31 + lag : 31 - lag; KS[((size_t)g * 63 + di) * 256 + (i & 255)] = f2bf(s); } }
        }
    }
}
__device__ void phase_s5a(const Params& p, char* smem) {
    int tid_ = threadIdx.x; asm volatile("" : "+v"(tid_)); const int tid = tid_, wid = tid >> 6, lane = tid & 63, fr = lane & 15, fq = lane >> 4;
    const bf16_t* UB = (const bf16_t*)(p.ws + E_UB); const bf16_t* MM = (const bf16_t*)(p.ws + OFF_TAB + T_MM); float* F = (float*)(p.ws + E_F);
    for (int it = blockIdx.x; it < 32 * 9; it += gridDim.x) { int g = it / 9, mt = it % 9; int d = wid >> 2;
        int R = mt * 64 + (wid & 3) * 16 + fr, b = R / 72, c = R % 72; size_t tok0 = (size_t)b * SALL + c * 32;
        f32x4 acc[8];
#pragma unroll
        for (int nf = 0; nf < 8; ++nf) acc[nf] = (f32x4){0.f, 0.f, 0.f, 0.f};
        const bf16_t* ub = UB + (tok0 + (fq >> 1)) * 512 + g * 16 + (fq & 1) * 8; const bf16_t* mm = MM + ((size_t)(g * 2 + d) * 128 + fr) * 512 + fq * 8;
#pragma unroll 2
        for (int ks = 0; ks < 16; ++ks) { bf16x8 af = *(const bf16x8*)(ub + (size_t)(2 * ks) * 512);
#pragma unroll
            for (int nf = 0; nf < 8; ++nf) { bf16x8 wf = *(const bf16x8*)(mm + (size_t)(nf * 16) * 512 + ks * 32); acc[nf] = __builtin_amdgcn_mfma_f32_16x16x32_bf16(wf, af, acc[nf], 0, 0, 0); } }
        float* fo = F + ((((size_t)b * 72 + c) * 32 + g) * 2 + d) * 128 + fq * 4;
#pragma unroll
        for (int nf = 0; nf < 8; ++nf) *(f32x4*)(fo + nf * 16) = acc[nf];
    }
}
constexpr int UL_STRIDE = 1040, HL_STRIDE = 528, L_HL = 80 * UL_STRIDE, L_S5B_END = L_HL + 80 * HL_STRIDE;
__device__ __forceinline__ float gelu_fast(float x) { float z = 0.7978845608028654f * (x + 0.044715f * x * x * x); return x * __builtin_amdgcn_rcpf(1.f + __builtin_amdgcn_exp2f(-2.f * 1.4426950408889634f * z)); }
__device__ void phase_s5b(const Params& p, char* smem) {
    int tid_ = threadIdx.x; asm volatile("" : "+v"(tid_)); const int tid = tid_, wid = tid >> 6, lane = tid & 63, fr = lane & 15, fq = lane >> 4;
    const bf16_t* UB = (const bf16_t*)(p.ws + E_UB); const bf16_t* NM = (const bf16_t*)(p.ws + OFF_TAB + T_NM); const bf16_t* KS = (const bf16_t*)(p.ws + OFF_TAB + T_KS);
    const float2* AP = (const float2*)(p.ws + OFF_TAB + T_AP); const float* F = (const float*)(p.ws + E_F); bf16_t* YB = (bf16_t*)(p.ws + E_YB);
    char* UL = smem; char* HL = smem + L_HL; float* FS = (float*)smem;
    for (int it = blockIdx.x; it < NB * 32; it += gridDim.x) { int b = it >> 5, g = it & 31;
        __syncthreads();
        for (int r = 0; r < 9; ++r) { int c = r * 8 + (tid >> 6); *(f32x4*)(FS + c * 256 + (tid & 63) * 4) = *(const f32x4*)(F + (((size_t)b * 72 + c) * 32 + g) * 256 + (tid & 63) * 4); }
        for (int i = tid; i < 8 * HL_STRIDE / 4; i += NTHR) ((unsigned*)(HL + 72 * HL_STRIDE))[i] = 0u;
        __syncthreads();
        if (tid < 128) { int d = tid >> 6, pp = tid & 63; float2 a32 = AP[(g * 2 + d) * 64 + pp]; float hr = 0.f, hi = 0.f;
            for (int i = 0; i < 72; ++i) { int c = d == 0 ? i : (i < 8 ? 7 - i : 79 - i);
                *(bf16_t*)(HL + c * HL_STRIDE + (d * 128 + pp) * 2) = f2bf(hr); *(bf16_t*)(HL + c * HL_STRIDE + (d * 128 + 64 + pp) * 2) = f2bf(hi);
                float fr_ = FS[c * 256 + d * 128 + pp], fi_ = FS[c * 256 + d * 128 + 64 + pp];
                float t = a32.x * hr - a32.y * hi + fr_; hi = a32.x * hi + a32.y * hr + fi_; hr = t; } }
        __syncthreads();
        for (int i = 0; i < 9; ++i) { int q = tid + 512 * i; int tok = q >> 1, half = q & 1; int c = tok >> 5, tau = tok & 31;
            *(uint4*)(UL + c * UL_STRIDE + (tau * 16 + half * 8) * 2) = *(const uint4*)(UB + ((size_t)b * SALL + tok) * 512 + g * 16 + half * 8); }
        for (int i = tid; i < 8 * UL_STRIDE / 4; i += NTHR) ((unsigned*)(UL + 72 * UL_STRIDE))[i] = 0u;
        __syncthreads();
        f32x4 acc[5][4];
#pragma unroll
        for (int mf = 0; mf < 5; ++mf)
#pragma unroll
            for (int nf = 0; nf < 4; ++nf) acc[mf][nf] = (f32x4){0.f, 0.f, 0.f, 0.f};
#pragma unroll 2
        for (int ks = 0; ks < 16; ++ks) { bf16x8 wf[4]; int tin = 2 * ks + (fq >> 1);
#pragma unroll
            for (int nf = 0; nf < 4; ++nf) { int delta = (4 * wid + nf) - tin + 31; wf[nf] = *(const bf16x8*)(KS + (((size_t)g * 63 + delta) * 16 + fr) * 16 + (fq & 1) * 8); }
#pragma unroll
            for (int mf = 0; mf < 5; ++mf) { bf16x8 af = *(const bf16x8*)(UL + (mf * 16 + fr) * UL_STRIDE + (ks * 32 + fq * 8) * 2);
#pragma unroll
                for (int nf = 0; nf < 4; ++nf) acc[mf][nf] = __builtin_amdgcn_mfma_f32_16x16x32_bf16(wf[nf], af, acc[mf][nf], 0, 0, 0); } }
#pragma unroll 2
        for (int ks = 0; ks < 8; ++ks) { bf16x8 wf[4];
#pragma unroll
            for (int nf = 0; nf < 4; ++nf) wf[nf] = *(const bf16x8*)(NM + ((size_t)g * 512 + (4 * wid + nf) * 16 + fr) * 256 + ks * 32 + fq * 8);
#pragma unroll
            for (int mf = 0; mf < 5; ++mf) { bf16x8 af = *(const bf16x8*)(HL + (mf * 16 + fr) * HL_STRIDE + (ks * 32 + fq * 8) * 2);
#pragma unroll
                for (int nf = 0; nf < 4; ++nf) acc[mf][nf] = __builtin_amdgcn_mfma_f32_16x16x32_bf16(wf[nf], af, acc[mf][nf], 0, 0, 0); } }
#pragma unroll
        for (int mf = 0; mf < 5; ++mf) { int c = mf * 16 + fr; if (c < 72) {
#pragma unroll
            for (int nf = 0; nf < 4; ++nf) { f32x4 v = acc[mf][nf];
#pragma unroll
                for (int j = 0; j < 4; ++j) v[j] = gelu_fast(v[j]);
                st_bf4(YB + ((size_t)b * SALL + c * 32 + 4 * wid + nf) * 512 + g * 16 + fq * 4, v); } } }
    }
}

__device__ void phase_mod(const Params& p, char* smem) {
    int tid_ = threadIdx.x; asm volatile("" : "+v"(tid_)); const int tid = tid_, wid = tid >> 6, lane = tid & 63;
    float* sc = (float*)smem;
    float* red = sc + 9 * 1024;
    __syncthreads();
    for (int i = tid; i < 9 * 1024; i += NTHR) { int r = i >> 10, k = i & 1023; float v = r < 8 ? p.in[1][r * 1024 + k] : p.in[3][k]; sc[i] = silu_f(v); }
    __syncthreads();
    for (int unit = blockIdx.x; unit < 4 * 48; unit += gridDim.x) { int l = unit / 48, cg = unit % 48, col = cg * 64 + lane;
        const float* W = p.in[5] + (size_t)l * 1024 * 3072 + col; float acc[9];
#pragma unroll
        for (int r = 0; r < 9; ++r) acc[r] = 0.f;
        for (int k0 = wid * 128; k0 < wid * 128 + 128; k0 += 16) { float wv[16];
#pragma unroll
            for (int i = 0; i < 16; ++i) wv[i] = W[(size_t)(k0 + i) * 3072];
#pragma unroll
            for (int i = 0; i < 16; ++i)
#pragma unroll
                for (int r = 0; r < 9; ++r) acc[r] += sc[r * 1024 + k0 + i] * wv[i]; }
#pragma unroll
        for (int r = 0; r < 9; ++r) red[(wid * 9 + r) * 64 + lane] = acc[r];
        __syncthreads();
        for (int i = tid; i < 9 * 64; i += NTHR) { int r = i >> 6, c = i & 63; float s = 0.f; for (int w = 0; w < 8; ++w) s += red[(w * 9 + r) * 64 + c];
            ((float*)(p.ws + OFF_MOD))[((size_t)l * 9 + r) * 3072 + cg * 64 + c] = s + p.in[6][l * 3072 + cg * 64 + c]; }
        __syncthreads();
    }
}
__device__ void phase_norm0(const Params& p, bf16_t* N) {
    int tid_ = threadIdx.x; asm volatile("" : "+v"(tid_)); const int tid = tid_, wid = tid >> 6, lane = tid & 63;
    const float* g = p.in[4]; float* SSX = (float*)(p.ws + OFF_SSX);
    for (int it = blockIdx.x; it < NTOK / 8; it += gridDim.x) { int r = it * 8 + wid; int b = r / SALL, s = r - b * SALL;
        bf16_t* xr = resid_row(p, r);
        const float* src = (s < CTX ? p.in[2] + (size_t)(b * CTX + s) * D : p.in[0] + (size_t)(b * SEQ + (s - CTX)) * D);
        const float* mod = (const float*)(p.ws + OFF_MOD) + (size_t)(s < CTX ? 8 : b) * 3072;
        f32x4 v[4]; float ss = 0.f;
#pragma unroll
        for (int i = 0; i < 4; ++i) { v[i] = *(const f32x4*)(src + lane * 4 + 256 * i); ss += v[i][0] * v[i][0] + v[i][1] * v[i][1] + v[i][2] * v[i][2] + v[i][3] * v[i][3]; }
#pragma unroll
        for (int o = 32; o; o >>= 1) ss += __shfl_xor(ss, o);
        if (lane < 16) SSX[(size_t)r * 16 + lane] = lane == 0 ? ss : 0.f;
#pragma unroll
        for (int i = 0; i < 4; ++i) { int k = lane * 4 + 256 * i; st_bf4(xr + k, v[i]);
            f32x4 gg = *(const f32x4*)(g + k), sc = *(const f32x4*)(mod + 1024 + k); f32x4 y;
#pragma unroll
            for (int j = 0; j < 4; ++j) y[j] = v[i][j] * gg[j] * (1.f + sc[j]);
            st_bf4(N + (size_t)r * 1024 + k, y); }
    }
}
__device__ void phase_shw(const Params& p) {
    int tid_ = threadIdx.x; asm volatile("" : "+v"(tid_)); const int tid = tid_, wid = tid >> 6, lane = tid & 63;
    const float* MOD = (const float*)(p.ws + OFF_MOD); float* SHW = (float*)(p.ws + OFF_SHW); float* GM = (float*)(p.ws + OFF_GM); const bf16_t* wb = (const bf16_t*)(p.ws + OFF_WBF);
    for (int i = blockIdx.x * NTHR + tid; i < 4 * 9 * 1024; i += gridDim.x * NTHR) { int l = i / 9216, r = (i / 1024) % 9, k = i & 1023; GM[i] = p.in[4][l * 1024 + k] * (1.f + MOD[((size_t)l * 9 + r) * 3072 + 1024 + k]); }
    const int gw = blockIdx.x * 8 + wid, nw = gridDim.x * 8;
    for (int c = gw; c < 2 * (3072 + 1792); c += nw) { int l, col; const bf16_t* W;
        if (c < 2 * 3072) { int e = c / 3072; col = c % 3072; l = 2 * e; W = wb + e * WE_SZ + WE_IN + (size_t)col * 1024; }
        else { int cc = c - 2 * 3072; int o = cc / 1792; col = cc % 1792; l = 2 * o + 1; W = wb + WO_BASE + o * WO_SZ + WO_IN + (size_t)col * 1024; }
        f32x4 w0, w1, w2, w3; { bf16x8 q0 = *(const bf16x8*)(W + lane * 16), q1 = *(const bf16x8*)(W + lane * 16 + 8); f32x4 t0, t1, t2, t3;
            u32x4v u0 = *(u32x4v*)&q0, u1 = *(u32x4v*)&q1;
            w0[0] = __uint_as_float(u0.x << 16); w0[1] = __uint_as_float(u0.x & 0xffff0000u); w0[2] = __uint_as_float(u0.y << 16); w0[3] = __uint_as_float(u0.y & 0xffff0000u);
            w1[0] = __uint_as_float(u0.z << 16); w1[1] = __uint_as_float(u0.z & 0xffff0000u); w1[2] = __uint_as_float(u0.w << 16); w1[3] = __uint_as_float(u0.w & 0xffff0000u);
            w2[0] = __uint_as_float(u1.x << 16); w2[1] = __uint_as_float(u1.x & 0xffff0000u); w2[2] = __uint_as_float(u1.y << 16); w2[3] = __uint_as_float(u1.y & 0xffff0000u);
            w3[0] = __uint_as_float(u1.z << 16); w3[1] = __uint_as_float(u1.z & 0xffff0000u); w3[2] = __uint_as_float(u1.w << 16); w3[3] = __uint_as_float(u1.w & 0xffff0000u); }
#pragma unroll 1
        for (int r = 0; r < 9; ++r) { const float* sh = MOD + ((size_t)l * 9 + r) * 3072 + lane * 16;
            f32x4 s0 = *(const f32x4*)sh, s1 = *(const f32x4*)(sh + 4), s2 = *(const f32x4*)(sh + 8), s3 = *(const f32x4*)(sh + 12); float a = 0.f;
#pragma unroll
            for (int j = 0; j < 4; ++j) a += s0[j] * w0[j] + s1[j] * w1[j] + s2[j] * w2[j] + s3[j] * w3[j];
#pragma unroll
            for (int o = 32; o; o >>= 1) a += __shfl_xor(a, o);
            if (lane == 0) SHW[((size_t)l * 9 + r) * 3072 + col] = a; }
    }
}
__device__ void phase_final(const Params& p) {
    int tid_ = threadIdx.x; asm volatile("" : "+v"(tid_)); const int tid = tid_, wid = tid >> 6, lane = tid & 63; const float* g = p.in[32];
    for (int it = blockIdx.x; it < NB * SEQ / 8; it += gridDim.x) { const size_t r = (size_t)(it * 8 + wid); const bf16_t* x = (const bf16_t*)(p.ws + OFF_X16) + r * 1024; float* o = p.xout + r * 1024;
        f32x4 v[4]; float ss = 0.f;
#pragma unroll
        for (int i = 0; i < 2; ++i) { const u32x4v q = *(const u32x4v*)(x + lane * 8 + 512 * i);
            v[2 * i][0] = __uint_as_float(q.x << 16); v[2 * i][1] = __uint_as_float(q.x & 0xffff0000u); v[2 * i][2] = __uint_as_float(q.y << 16); v[2 * i][3] = __uint_as_float(q.y & 0xffff0000u);
            v[2 * i + 1][0] = __uint_as_float(q.z << 16); v[2 * i + 1][1] = __uint_as_float(q.z & 0xffff0000u); v[2 * i + 1][2] = __uint_as_float(q.w << 16); v[2 * i + 1][3] = __uint_as_float(q.w & 0xffff0000u); }
#pragma unroll
        for (int i = 0; i < 4; ++i) ss += v[i][0] * v[i][0] + v[i][1] * v[i][1] + v[i][2] * v[i][2] + v[i][3] * v[i][3];
#pragma unroll
        for (int o2 = 32; o2; o2 >>= 1) ss += __shfl_xor(ss, o2);
        float rstd = 1.0f / sqrtf(ss * (1.f / 1024.f) + 1e-6f);
#pragma unroll
        for (int i = 0; i < 4; ++i) { int k = lane * 8 + 512 * (i >> 1) + 4 * (i & 1); f32x4 gg = *(const f32x4*)(g + k); f32x4 y;
#pragma unroll
            for (int j = 0; j < 4; ++j) y[j] = v[i][j] * rstd * gg[j];
            *(f32x4*)(o + k) = y; }
    }
}


#define XB_TMO      128
#define XB_XCNT(j)  (256  + 64 * (j))
#define XB_XSUB(j)  (1280 + 64 * (j))
#define XB_XGEN(j)  (2304 + 64 * (j))
#define XB_TOP      3328
#define XB_TOPGEN   3392
#define XCD_BAR_WORDS 3456
#define XB_SPIN_CAP (1u << 22)
#define LAS __attribute__((address_space(3)))
__device__ __forceinline__ unsigned xb_ld(unsigned* p)              { return __hip_atomic_load(p, __ATOMIC_RELAXED, __HIP_MEMORY_SCOPE_AGENT); }
__device__ __forceinline__ unsigned xb_add(unsigned* p, unsigned v) { return __hip_atomic_fetch_add(p, v, __ATOMIC_RELAXED, __HIP_MEMORY_SCOPE_AGENT); }
__device__ __forceinline__ unsigned xb_xcc_id() { return (unsigned)__builtin_amdgcn_s_getreg((3 << 11) | 20) & 0xFu; }
#define XB_SPIN(cond, bar) do { unsigned _sp = 0; while (cond) { __builtin_amdgcn_s_sleep(1); \
    if ((++_sp & 255u) == 0u) { if (xb_ld(&(bar)[XB_TMO])) break; if (_sp > XB_SPIN_CAP) { atomicAdd(&(bar)[XB_TMO], 1u); break; } } } } while (0)
struct XcdBarrier { unsigned* bar; unsigned x; volatile LAS unsigned* st; };
__device__ __forceinline__ XcdBarrier xcd_barrier_post(unsigned* bar, volatile LAS unsigned* st) {
    XcdBarrier b; b.bar = bar; b.x = xb_xcc_id(); b.st = st;
    if (threadIdx.x == 0) (void)xb_add(&bar[XB_XCNT(b.x)], 1u);
    return b;
}
__device__ __forceinline__ void xcd_barrier_complete(unsigned* bar, unsigned x, unsigned& nloc, unsigned& nx) {
    const unsigned G = gridDim.x * gridDim.y * gridDim.z;
    unsigned sum, cnt, mine, sp = 0u;
    for (;;) {
        sum = 0u; cnt = 0u; mine = 0u;
#pragma unroll 1
        for (unsigned j = 0; j < 16; ++j) { const unsigned c = xb_ld(&bar[XB_XCNT(j)]); sum += c; cnt += (c > 0u) ? 1u : 0u; }
        mine = xb_ld(&bar[XB_XCNT(x)]);
        if (sum == G) break;
        __builtin_amdgcn_s_sleep(1);
        if ((++sp & 255u) == 0u) { if (xb_ld(&bar[XB_TMO])) break; if (sp > XB_SPIN_CAP) { atomicAdd(&bar[XB_TMO], 1u); break; } }
    }
    nloc = mine > 0u ? mine : 1u; nx = cnt > 0u ? cnt : 1u;
}
__device__ __forceinline__ void xcd_barrier(const XcdBarrier& b) {
    asm volatile("s_waitcnt vmcnt(0)" ::: "memory");
    __syncthreads();
    if (threadIdx.x == 0) {
        unsigned* bar = b.bar;
        __builtin_amdgcn_s_waitcnt(0);
        unsigned nloc = b.st[0], nx = b.st[1];
        if (nloc == 0u) { xcd_barrier_complete(bar, b.x, nloc, nx); b.st[0] = nloc; b.st[1] = nx; }
        const unsigned old = xb_add(&bar[XB_XSUB(b.x)], 1u);
        const unsigned gen = old / nloc;
        if (old + 1u == (gen + 1u) * nloc) {
            __builtin_amdgcn_fence(__ATOMIC_RELEASE, "agent");
            asm volatile("s_waitcnt vmcnt(0)" ::: "memory");
            const unsigned og = xb_add(&bar[XB_TOP], 1u);
            const unsigned tg = og / nx;
            if (og + 1u == (tg + 1u) * nx) xb_add(&bar[XB_TOPGEN], 1u);
            else XB_SPIN(xb_ld(&bar[XB_TOPGEN]) == tg, bar);
            __builtin_amdgcn_fence(__ATOMIC_ACQUIRE, "agent");
            xb_add(&bar[XB_XGEN(b.x)], 1u);
            asm volatile("s_waitcnt vmcnt(0)" ::: "memory");
        } else {
            XB_SPIN(xb_ld(&bar[XB_XGEN(b.x)]) == gen, bar);
            __builtin_amdgcn_fence(__ATOMIC_ACQUIRE, "agent");
            asm volatile("s_waitcnt vmcnt(0)" ::: "memory");
        }
    }
    __syncthreads();
}

namespace cg = cooperative_groups;
#define GRID_SYNC() do { int nb_ = (PROBE == 12) ? 2 : 1; asm volatile("" : "+s"(nb_)); for (int i_ = 0; i_ < nb_; ++i_) xcd_barrier(xb); } while (0)
#ifndef PROBE
#define PROBE 0
#endif
#ifndef PV
#define PV 1
#endif
__global__ void __launch_bounds__(NTHR) mega(Params p_arg) {
    extern __shared__ __attribute__((aligned(16))) char smem[];
    const Params& p = *(const Params*)__builtin_amdgcn_kernarg_segment_ptr();
    cg::grid_group grid = cg::this_grid();
    char* ws = p.ws; const bf16_t* wb = (const bf16_t*)(ws + OFF_WBF);
    const float2* rtab = (const float2*)(ws + OFF_ROPE);
    volatile LAS unsigned* xst = (volatile LAS unsigned*)(smem + SMEM_BYTES - 16);
    if (threadIdx.x == 0) { xst[0] = 0u; xst[1] = 0u; }
    __syncthreads();
    XcdBarrier xb = xcd_barrier_post((unsigned*)(ws + OFF_BAR), xst);
    if (p.ws == nullptr) grid.sync();
#pragma unroll 1
    for (int l = -1; l < DEPTH; ++l) {
        const int nsub = l < 0 ? 1 : ((l & 1) ? 4 : (l == 0 ? 6 : 5));
#pragma unroll 1
        for (int sub = 0; sub < nsub; ++sub) {
            char* ws = p.ws; asm volatile("" : "+s"(ws));
            const bf16_t* wb = (const bf16_t*)(ws + OFF_WBF); const float2* rtab = (const float2*)(ws + OFF_ROPE);
            const float* SSX = (const float*)(ws + OFF_SSX); bf16_t* ANX = (bf16_t*)(ws + OFF_ACT);
            const float* mod = (const float*)(ws + OFF_MOD) + (size_t)(l < 0 ? 0 : l) * 9 * 3072;
            const float* shw_l = (const float*)(ws + OFF_SHW) + (size_t)(l < 0 ? 0 : l) * 9 * 3072;
            const float* gm_next = (l >= 0 && l + 1 < DEPTH) ? (const float*)(ws + OFF_GM) + (size_t)(l + 1) * 9 * 1024 : nullptr;
            if (l < 0) { phase_prep_weights(p, smem); phase_mod(p, smem); }
            else if ((l & 1) == 0) {
                const int e = l >> 1; const bf16_t* we = wb + e * WE_SZ;
                const int s2 = (l == 0) ? sub : sub + 1;
                if (s2 == 0) { phase_norm0(p, ANX); phase_shw(p); }
                else if (s2 == 1) gemm_phase<4, 4>((const bf16_t*)(ws + E_N), 1024, we + WE_IN, 1024, NTOK, 3072, 1024, VEpiEvenIn{(bf16_t*)p.xout, (bf16_t*)(ws + E_UB), (bf16_t*)(ws + E_MRG), SSX, shw_l}, smem, rtab);
                else if (s2 == 2) { phase_conv(p, e); gemm_phase<3, 8, VEpiS5F, 1>((const bf16_t*)(ws + E_UB), 0, (const bf16_t*)(ws + OFF_TAB + T_MM), 512, 576, 8192, 512, VEpiS5F{(float*)(ws + E_F)}, smem, rtab); }
                else if (s2 == 3) { phase_lru(p, e, smem, 0); phase_s5b(p, smem); }
                else if (s2 == 4) gemm_phase<2, 1>((const bf16_t*)(ws + E_YB), 512, we + WE_GLU, 512, NTOK, 512, 512, VEpiGlu{(const bf16_t*)(ws + E_YB), (bf16_t*)(ws + E_MRG), p.in[24] + e * 512}, smem, rtab);
                else gemm_phase<3, 2>((const bf16_t*)(ws + E_MRG), 1536, we + WE_OUT, 1536, NTOK, 1024, 1536, VEpiResid{p, mod, gm_next, ANX, (float*)(ws + OFF_SSX)}, smem, rtab);
            } else {
                const int o = l >> 1; const bf16_t* wo = wb + WO_BASE + o * WO_SZ; float* SSP = (float*)(ws + O_SSP);
                if (sub == 0) gemm_phase<4, 2>((const bf16_t*)(ws + O_N), 1024, wo + WO_IN, 1024, NTOK, 1792, 1024, VEpiMlaIn{(bf16_t*)(ws + O_CQ), (bf16_t*)(ws + O_CKV), (bf16_t*)(ws + O_KR), (bf16_t*)(ws + O_MSG), SSP, SSX, shw_l}, smem, rtab);
                else if (sub == 1) {
                    gemm_phase<3, 1>((const bf16_t*)(ws + O_CQ), 384, wo + WO_UQ, 384, NTOK, 1536, 384, VEpiRowScale{(bf16_t*)p.xout, QW, SSP, 0, 6, 1.f / 384.f, 192}, smem, rtab);
                    gemm_phase<3, 1>((const bf16_t*)(ws + O_CKV), 256, wo + WO_UKV, 256, NTOK, 2048, 256, VEpiRowScale{(bf16_t*)(ws + O_KV), KVW, SSP, 6, 4, 1.f / 256.f, 0}, smem, rtab);
                }
                else if (sub == 2) phase_attn(p, l < DEPTH - 1, smem);
                else gemm_phase<3, 2>((const bf16_t*)(ws + O_MSG), 1024, wo + WO_OUT, 1024, NTOK, 1024, 1024, VEpiResid{p, mod, gm_next, ANX, (float*)(ws + OFF_SSX)}, smem, rtab);
            }
            { const int tabe = (l == 0 && sub == 0) ? 0 : ((l == 1 && sub == 1) ? 1 : -1);
              if (tabe >= 0) phase_s5_tables(p, tabe, smem); }
            xcd_barrier(xb);
        }
    }
    phase_final(p);
}

extern "C" void kernel_launch(void* const* d_in, const int* in_sizes, int n_in, void* d_out, int out_size, void* d_ws, size_t ws_size, hipStream_t stream) {
    if (n_in != 33 || ws_size < WS_NEED) { fprintf(stderr, "kernel_launch: bad args n_in=%d ws=%zu need=%zu\n", n_in, ws_size, (size_t)WS_NEED); return; }
    Params p{}; for (int i = 0; i < 33; ++i) p.in[i] = (const float*)d_in[i]; p.xout = (float*)d_out; p.ws = (char*)d_ws;
    static int grid_blocks = 0;
    if (!grid_blocks) {
        if (hipFuncSetAttribute((const void*)mega, hipFuncAttributeMaxDynamicSharedMemorySize, SMEM_BYTES) != hipSuccess) { fprintf(stderr, "kernel_launch: hipFuncSetAttribute failed\n"); return; }
        int dev = 0, cus = 0, per_cu = 0;
        (void)hipGetDevice(&dev); (void)hipDeviceGetAttribute(&cus, hipDeviceAttributeMultiprocessorCount, dev);
        (void)hipOccupancyMaxActiveBlocksPerMultiprocessor(&per_cu, mega, NTHR, SMEM_BYTES);
        if (per_cu < 1 || cus < 8) { fprintf(stderr, "kernel_launch: occupancy query gave %d blocks/CU on %d CUs\n", per_cu, cus); return; }
        grid_blocks = (cus / 8) * 8;
    }
    (void)hipMemsetAsync((char*)d_ws + OFF_BAR, 0, XCD_BAR_WORDS * 4, stream);
    void* args[] = {&p};
    hipError_t e = hipLaunchCooperativeKernel((const void*)mega, dim3(grid_blocks), dim3(NTHR), args, SMEM_BYTES, stream);
    if (e != hipSuccess) fprintf(stderr, "kernel_launch: cooperative launch failed: %s (grid %d)\n", hipGetErrorString(e), grid_blocks);
}
```
